# Optimizing an MI355X kernel written in HIP

```python
import math
import jax, jax.numpy as jnp
from jax import lax
import numpy as np

D_MODEL = 1024
BATCH = 16
SEQ = 2048
DEPTH = 1

D_MIX = D_MODEL
D_SSM = D_MIX // 2
SSM_GROUP = 16
N_SSM_GROUPS = D_SSM // SSM_GROUP
SSM_STATE = 64
N_DIR = 2
D_FOURIER = D_MIX - D_SSM
N_FOURIER_HEADS = 4
FOURIER_HEAD_DIM = D_FOURIER // N_FOURIER_HEADS
D_FF = 2816
CONV_WIDTH = 3
RMS_EPS = 1e-6
DT_MIN = 1e-3
DT_MAX = 1e-1

kernel_name = "hymba_style_s5_fnet_convffn_encoder"


def rmsnorm(x, g):
    xf = x.astype(jnp.float32)
    y = xf * lax.rsqrt(jnp.mean(xf * xf, axis=-1, keepdims=True) + RMS_EPS)
    return (y * g.astype(jnp.float32)).astype(x.dtype)


def _ssm_combine(left, right):
    a_l, b_l = left
    a_r, b_r = right
    return a_r * a_l, a_r * b_l + b_r


def s5_direction(uf, lam_re, lam_im, log_dt, b_re, b_im, c_re, c_im, reverse):
    f32 = jnp.float32
    lam = lax.complex(lam_re.astype(f32), lam_im.astype(f32))
    dt = jnp.exp(log_dt.astype(f32))[:, None]
    lam_bar = jnp.exp(lam * dt)
    b = lax.complex(b_re.astype(f32), b_im.astype(f32))
    b_bar = ((lam_bar - 1.0) / lam)[..., None] * b
    c = lax.complex(c_re.astype(f32), c_im.astype(f32))
    bu = jnp.einsum('gph,blgh->blgp', b_bar, uf)
    a = jnp.broadcast_to(lam_bar, (1, uf.shape[1]) + lam_bar.shape)
    _, states = lax.associative_scan(_ssm_combine, (a, bu), reverse=reverse, axis=1)
    return jnp.einsum('ghp,blgp->blgh', c, states).real


def s5_mixer(u, lam_re, lam_im, log_dt, b_re, b_im, c_re, c_im, d_skip, w_glu, b_glu):
    bsz, L, _ = u.shape
    uf = u.astype(jnp.float32)
    ug = uf.reshape(bsz, L, N_SSM_GROUPS, SSM_GROUP)
    y = (s5_direction(ug, lam_re[0], lam_im[0], log_dt[0], b_re[0], b_im[0], c_re[0], c_im[0], False)
         + s5_direction(ug, lam_re[1], lam_im[1], log_dt[1], b_re[1], b_im[1], c_re[1], c_im[1], True))
    y = (y.reshape(bsz, L, D_SSM) + d_skip.astype(jnp.float32) * uf).astype(u.dtype)
    z = jax.nn.gelu(y)
    return z * jax.nn.sigmoid(z @ w_glu + b_glu)


def fourier_mixer(v, w_fourier):
    bsz, L, _ = v.shape
    vh = v.astype(jnp.float32).reshape(bsz, L, N_FOURIER_HEADS, FOURIER_HEAD_DIM)
    mixed = jnp.fft.fft2(vh, axes=(1, 3), norm='ortho').real.astype(v.dtype)
    out = jnp.einsum('blhc,hcd->blhd', mixed, w_fourier)
    return out.reshape(bsz, L, D_FOURIER)


def conv_ffn(h, w_up, conv_w, conv_b, w_down):
    L = h.shape[1]
    up = h @ w_up
    half = CONV_WIDTH // 2
    padded = jnp.pad(up, ((0, 0), (half, half), (0, 0)))
    conv = conv_b
    for k in range(CONV_WIDTH):
        conv = conv + conv_w[k] * padded[:, k:k + L]
    gate, val = jnp.split(conv, 2, axis=-1)
    return (jax.nn.gelu(gate) * val) @ w_down


def setup_inputs(seed: int = 0) -> dict:
    key = jax.random.key(seed)
    ks = jax.random.split(key, 24)
    f32 = jnp.float32
    G, P, H = N_SSM_GROUPS, SSM_STATE, SSM_GROUP

    def nrm(k, shape, scale):
        return jax.random.normal(k, shape, f32) * scale

    x = jax.random.normal(ks[0], (BATCH, SEQ, D_MODEL), f32)
    g_mix = 1.0 + nrm(ks[1], (DEPTH, D_MODEL), 0.02)
    w_in = nrm(ks[2], (DEPTH, D_MODEL, D_MIX), D_MODEL ** -0.5)
    ssm_lam_re = -0.5 * jnp.exp(nrm(ks[3], (DEPTH, N_DIR, G, P), 0.05))
    n_idx = jnp.arange(P, dtype=f32)
    ssm_lam_im = math.pi * n_idx + nrm(ks[4], (DEPTH, N_DIR, G, P), 0.01)
    ssm_log_dt = jax.random.uniform(ks[5], (DEPTH, N_DIR, G), f32,
                                    math.log(DT_MIN), math.log(DT_MAX))
    b_scale = (2.0 * H) ** -0.5
    ssm_b_re = nrm(ks[6], (DEPTH, N_DIR, G, P, H), b_scale)
    ssm_b_im = nrm(ks[7], (DEPTH, N_DIR, G, P, H), b_scale)
    c_scale = P ** -0.5
    ssm_c_re = nrm(ks[8], (DEPTH, N_DIR, G, H, P), c_scale)
    ssm_c_im = nrm(ks[9], (DEPTH, N_DIR, G, H, P), c_scale)
    ssm_d = nrm(ks[10], (DEPTH, D_SSM), 1.0)
    w_glu = nrm(ks[11], (DEPTH, D_SSM, D_SSM), D_SSM ** -0.5)
    b_glu = nrm(ks[12], (DEPTH, D_SSM), 0.02)
    w_fourier = nrm(ks[13], (DEPTH, N_FOURIER_HEADS, FOURIER_HEAD_DIM, FOURIER_HEAD_DIM),
                    FOURIER_HEAD_DIM ** -0.5)
    w_out = nrm(ks[14], (DEPTH, D_MIX, D_MODEL), D_MIX ** -0.5)
    g_ffn = 1.0 + nrm(ks[15], (DEPTH, D_MODEL), 0.02)
    w_up = nrm(ks[16], (DEPTH, D_MODEL, 2 * D_FF), D_MODEL ** -0.5)
    conv_w = nrm(ks[17], (DEPTH, CONV_WIDTH, 2 * D_FF), CONV_WIDTH ** -0.5)
    conv_b = nrm(ks[18], (DEPTH, 2 * D_FF), 0.02)
    w_down = nrm(ks[19], (DEPTH, D_FF, D_MODEL), D_FF ** -0.5)
    g_final = 1.0 + nrm(ks[20], (D_MODEL,), 0.02)
    return {
        "x": x, "g_mix": g_mix, "w_in": w_in,
        "ssm_lam_re": ssm_lam_re, "ssm_lam_im": ssm_lam_im, "ssm_log_dt": ssm_log_dt,
        "ssm_b_re": ssm_b_re, "ssm_b_im": ssm_b_im, "ssm_c_re": ssm_c_re, "ssm_c_im": ssm_c_im,
        "ssm_d": ssm_d, "w_glu": w_glu, "b_glu": b_glu, "w_fourier": w_fourier,
        "w_out": w_out, "g_ffn": g_ffn, "w_up": w_up, "conv_w": conv_w, "conv_b": conv_b,
        "w_down": w_down, "g_final": g_final,
    }


def reference(x, g_mix, w_in, ssm_lam_re, ssm_lam_im, ssm_log_dt, ssm_b_re, ssm_b_im,
              ssm_c_re, ssm_c_im, ssm_d, w_glu, b_glu, w_fourier, w_out, g_ffn, w_up,
              conv_w, conv_b, w_down, g_final):
    h = x
    for i in range(DEPTH):
        xn = rmsnorm(h, g_mix[i])
        proj = xn @ w_in[i]
        u = proj[..., :D_SSM]
        v = proj[..., D_SSM:]
        y_ssm = s5_mixer(u, ssm_lam_re[i], ssm_lam_im[i], ssm_log_dt[i], ssm_b_re[i],
                         ssm_b_im[i], ssm_c_re[i], ssm_c_im[i], ssm_d[i], w_glu[i], b_glu[i])
        y_fft = fourier_mixer(v, w_fourier[i])
        h = h + jnp.concatenate([y_ssm, y_fft], axis=-1) @ w_out[i]
        h = h + conv_ffn(rmsnorm(h, g_ffn[i]), w_up[i], conv_w[i], conv_b[i], w_down[i])
    return rmsnorm(h, g_final)
```

```cpp
#include <hip/hip_runtime.h>
#include <hip/hip_cooperative_groups.h>
#include <cstdio>
namespace cg = cooperative_groups;

#ifndef ONE_LAUNCH
#define ONE_LAUNCH 1
#endif
#ifndef SLOW_GEMM
#define SLOW_GEMM 0
#endif
#ifndef GEMM_SP2
#define GEMM_SP2 1
#endif

#define LAS __attribute__((address_space(3)))
typedef unsigned short bf16_t;
typedef short bf16x8 __attribute__((ext_vector_type(8)));
typedef float f32x4 __attribute__((ext_vector_type(4)));
typedef unsigned u32x4 __attribute__((ext_vector_type(4)));
typedef unsigned u32x2 __attribute__((ext_vector_type(2)));

constexpr int NTOK = 32768, DM = 1024, NUP = 5632, DFF = 2816, UK = 768;
constexpr float EPS = 1e-6f;
constexpr int BM = 256, BK = 64, HALF = 128, HTB = HALF * BK * 2, STAGE_BYTES = 8 * HTB;
constexpr int LDS_BYTES = STAGE_BYTES + 18432;
constexpr int NPH = 11;

constexpr size_t O_WIN = 0;
constexpr size_t O_WGLU = O_WIN + (size_t)1536 * 1024 * 2;
constexpr size_t O_WOUT = O_WGLU + (size_t)512 * 512 * 2;
constexpr size_t O_WUP = O_WOUT + (size_t)1024 * 1024 * 2;
constexpr size_t O_WDN = O_WUP + (size_t)5632 * 1024 * 2;
constexpr size_t O_AL = O_WDN + (size_t)1024 * 2816 * 2;
constexpr size_t O_WST = O_AL + (size_t)2048 * 4096 * 2;
constexpr size_t O_WY = O_WST + (size_t)32 * 256 * 512 * 2;
constexpr size_t O_KTAB = O_WY + (size_t)32 * 512 * 768 * 2;
constexpr size_t O_SS1 = O_KTAB + (size_t)32 * 2 * 32 * 256 * 4;
constexpr size_t O_SS2 = O_SS1 + (size_t)32768 * 16 * 4;
constexpr size_t O_EB = O_SS2 + (size_t)32768 * 16 * 4;
constexpr size_t O_XN = O_EB + (size_t)128 * 4 * 5632 * 4;
constexpr size_t O_CAT = O_XN + (size_t)32768 * 1024 * 2;
constexpr size_t O_U = O_CAT + (size_t)32768 * 1024 * 2;
constexpr size_t O_PQT = O_U + (size_t)32 * 1024 * 768 * 2;
constexpr size_t O_SLOC = O_PQT + (size_t)8192 * 4096 * 2;
constexpr size_t O_Z = O_SLOC + (size_t)32 * 1024 * 256 * 4;
constexpr size_t O_ACT = O_U;
constexpr size_t O_BAR = O_Z + (size_t)32768 * 512 * 2;
constexpr size_t BAR_BYTES = 65536;
constexpr size_t WS_NEED = O_BAR + BAR_BYTES;

struct Params {
    const float *x, *g_mix, *w_in, *lam_re, *lam_im, *log_dt, *b_re, *b_im, *c_re, *c_im, *ssm_d, *w_glu, *b_glu, *w_fourier, *w_out, *g_ffn, *w_up, *conv_w, *conv_b, *w_down, *g_final;
    float* out; unsigned char* ws;
};

__device__ __forceinline__ unsigned cvt_pk_bf16(float lo, float hi) { unsigned r; asm volatile("v_cvt_pk_bf16_f32 %0, %1, %2" : "=v"(r) : "v"(lo), "v"(hi)); return r; }
__device__ __forceinline__ bf16_t f2bf(float f) { return (bf16_t)(cvt_pk_bf16(f, 0.f) & 0xffffu); }
__device__ __forceinline__ float bflo(unsigned w) { return __uint_as_float(w << 16); }
__device__ __forceinline__ float bfhi(unsigned w) { return __uint_as_float(w & 0xffff0000u); }
__device__ __forceinline__ float gelu_t(float x) {
    const float u = x * (1.0f + 0.044715f * x * x);
    const float e = __builtin_amdgcn_exp2f(-2.0f * 0.7978845608f * 1.4426950409f * u);
    return x * __builtin_amdgcn_rcpf(1.0f + e);
}
typedef float f32x2 __attribute__((ext_vector_type(2)));
template <int CTRL> __device__ __forceinline__ float dpp_rot(float src) { return __int_as_float(__builtin_amdgcn_mov_dpp(__float_as_int(src), CTRL, 0xf, 0xf, false)); }
__device__ __forceinline__ f32x2 gelu_t2(f32x2 x) {
    const f32x2 u = x * (x * x * 0.044715f + 1.0f), a = u * (-2.0f * 0.7978845608f * 1.4426950409f);
    f32x2 e; e[0] = __builtin_amdgcn_exp2f(a[0]); e[1] = __builtin_amdgcn_exp2f(a[1]);
    const f32x2 d = e + 1.0f; f32x2 r; r[0] = __builtin_amdgcn_rcpf(d[0]); r[1] = __builtin_amdgcn_rcpf(d[1]);
    return x * r;
}
template <int CTRL> __device__ __forceinline__ float dpp_mov(float src) { return __int_as_float(__builtin_amdgcn_update_dpp(0, __float_as_int(src), CTRL, 0xf, 0xf, false)); }
template <int CTRL> __device__ __forceinline__ float dpp_upd(float old, float src) { return __int_as_float(__builtin_amdgcn_update_dpp(__float_as_int(old), __float_as_int(src), CTRL, 0xf, 0xf, false)); }
__device__ __forceinline__ float sigmoid_f(float g) { return __builtin_amdgcn_rcpf(1.0f + __builtin_amdgcn_exp2f(-1.4426950409f * g)); }

__device__ __forceinline__ int lds_byte(int r, int c) { const int st = (r >> 4) * 2 + (c >> 5), rr = r & 15, cc = c & 31, ob = rr * 64 + cc * 2; return st * 1024 + (ob ^ (((ob >> 9) & 1) << 5)); }
__device__ __forceinline__ void stage_rc(int b, int& R, int& C) { const int st = b / 1024, sb = b % 1024, swz = sb ^ (((sb >> 9) & 1) << 5); R = (st >> 1) * 16 + swz / 64; C = (st & 1) * 32 + (swz % 64) / 2; }
__device__ __forceinline__ int perm32(int rho) { const int n = rho >> 4, i = rho & 15; return 8 * (i >> 2) + 4 * n + (i & 3); }

struct Unit { const char* A; const char* B; int pm, pn, aux; };
struct Order {
    const char* A; const char* B; int nM, nN, nBatch; size_t bA, bB, sA, sB; int G, c; int rot = 0;
    __device__ __forceinline__ bool next(int i, Unit& u) const {
        const int per = nM * nN; long L = (long)i * G + c;
        if (nBatch > 1 && per <= G / 8 && (G / 8) % per == 0) {
            const int xcd = c & 7, slot = c >> 3, bpx = (G / 8) / per, b = i * 8 * bpx + (slot / per) * 8 + xcd;
            if (b >= nBatch) return false;
            L = (long)b * per + slot % per;
        }
        if (L >= (long)per * nBatch) return false;
        const int bt = (int)(L / per); int w = (int)(L % per); int pm, pn;
        if (nBatch == 1) {
            const int nwg = per; int wgid = w; { const int q = nwg / 8, r = nwg % 8, xcd = wgid % 8, off = wgid / 8; wgid = (xcd < r ? xcd * (q + 1) : r * (q + 1) + (xcd - r) * q) + off; }
            const int nig = 8 * nN, gid = wgid / nig, fm = gid * 8, gsz = (nM - fm) < 8 ? (nM - fm) : 8;
            pm = fm + ((wgid % nig) % gsz); pn = (wgid % nig) / gsz;
            if (rot && (i & 1)) pn = (pn + nN / 2) % nN;
        } else { pm = w / nN; pn = w % nN; }
        u.pm = pm; u.pn = pn; u.aux = bt; u.A = A + (size_t)bt * bA + (size_t)pm * sA; u.B = B + (size_t)bt * bB + (size_t)pn * sB; return true;
    }
};

template <class Epi>
__device__ __forceinline__ void gemm_phase(LAS unsigned char* lds, const int K, const int lda, const int ldb, const Order& S, const Epi& E) {
    int tid_ = threadIdx.x; asm volatile("" : "+v"(tid_));
    const int tid = tid_, wid = __builtin_amdgcn_readfirstlane(tid >> 6), lane = tid & 63, wr = wid >> 2, wc = wid & 3, fr = lane & 15, fq = lane >> 4;
    Unit cur, nxt; int ui = 0;
    if (!S.next(0, cur)) return;
    f32x4 acc[2][2][4][2];
#if SLOW_GEMM
    for (;;) {
#pragma unroll
        for (int ai = 0; ai < 2; ++ai)
#pragma unroll
            for (int bj = 0; bj < 2; ++bj)
#pragma unroll
                for (int m = 0; m < 4; ++m)
#pragma unroll
                    for (int n = 0; n < 2; ++n)
#pragma unroll
                        for (int e = 0; e < 4; ++e) {
                            const int row = 128 * ai + 64 * wr + 16 * m + fr, col = Epi::PERM ? (128 * bj + 32 * wc + 8 * fq + 4 * n + e) : (128 * bj + 32 * wc + 16 * n + 4 * fq + e);
                            const u32x4* ap = (const u32x4*)(cur.A + (size_t)row * lda * 2); const u32x4* bp = (const u32x4*)(cur.B + (size_t)col * ldb * 2);
                            float s = 0.f;
                            for (int k = 0; k < K / 8; ++k) { const u32x4 a = ap[k], b = bp[k];
                                s += bflo(a.x) * bflo(b.x) + bfhi(a.x) * bfhi(b.x) + bflo(a.y) * bflo(b.y) + bfhi(a.y) * bfhi(b.y) + bflo(a.z) * bflo(b.z) + bfhi(a.z) * bfhi(b.z) + bflo(a.w) * bflo(b.w) + bfhi(a.w) * bfhi(b.w); }
                            acc[ai][bj][m][n][e] = s;
                        }
        E(acc, cur, wr, wc, fr, fq);
        if (!S.next(++ui, nxt)) break;
        cur = nxt;
    }
    if (wr == 0) __builtin_amdgcn_s_barrier();
    __builtin_amdgcn_s_barrier();
#else
    int nt = K / BK; asm volatile("" : "+s"(nt));
    unsigned voffA[2], voffB[2];
#pragma unroll
    for (int i = 0; i < 2; ++i) { int R, C; stage_rc(tid * 16 + i * 8192, R, C); const int Rb = Epi::PERM ? ((R & ~31) + perm32(R & 31)) : R;
        voffA[i] = (unsigned)(R * lda + C) * 2u; voffB[i] = (unsigned)(Rb * ldb + C) * 2u; }
    const size_t kstep = (size_t)(BK * 2);
    const size_t hA = (size_t)HALF * lda * 2, hB = (size_t)HALF * ldb * 2;
    const unsigned ldsw = (unsigned)wid * 1024u;
    const int aoff = lds_byte(wr * 64 + fr, fq * 8), boff = lds_byte(wc * 32 + fr, fq * 8);
#define PG8_SA(b, h) (((b) * 2 + (h)) * HTB)
#define PG8_SB(b, h) ((4 + (b) * 2 + (h)) * HTB)
#define PG8_STAGE(bufoff, gbase, voff) do { _Pragma("unroll") for (int _i = 0; _i < 2; ++_i) \
        __builtin_amdgcn_global_load_lds((const unsigned*)((const char*)(gbase) + (voff)[_i]), (LAS unsigned*)(lds + (bufoff) + ldsw + _i * 8192), 16, 0, 0); } while (0)
#define PG8_LDA(dst, b, h) do { _Pragma("unroll") for (int m = 0; m < 4; ++m) _Pragma("unroll") for (int k = 0; k < 2; ++k) dst[m][k] = *(const LAS bf16x8*)(lds + PG8_SA(b, h) + aoff + m * 2048 + k * 1024); } while (0)
#define PG8_LDB(dst, b, h) do { _Pragma("unroll") for (int n = 0; n < 2; ++n) _Pragma("unroll") for (int k = 0; k < 2; ++k) dst[n][k] = *(const LAS bf16x8*)(lds + PG8_SB(b, h) + boff + n * 2048 + k * 1024); } while (0)
#define PG8_MMA(ai, bj, At, Bt) do { __builtin_amdgcn_s_setprio(1); _Pragma("unroll") for (int m = 0; m < 4; ++m) _Pragma("unroll") for (int n = 0; n < 2; ++n) _Pragma("unroll") for (int k = 0; k < 2; ++k) \
        acc[ai][bj][m][n] = __builtin_amdgcn_mfma_f32_16x16x32_bf16(Bt[n][k], At[m][k], acc[ai][bj][m][n], 0, 0, 0); __builtin_amdgcn_s_setprio(0); } while (0)
#define PG8_WAIT_V(n) asm volatile("s_waitcnt vmcnt(" #n ")" ::: "memory")
#define PG8_WAIT_L(n) asm volatile("s_waitcnt lgkmcnt(" #n ")" ::: "memory")
#define PG8_BAR __builtin_amdgcn_s_barrier()
#define PG8_SCHED __builtin_amdgcn_sched_barrier(0)
#pragma unroll
    for (int a = 0; a < 2; ++a)
#pragma unroll
        for (int b = 0; b < 2; ++b)
#pragma unroll
            for (int m = 0; m < 4; ++m)
#pragma unroll
                for (int n = 0; n < 2; ++n) acc[a][b][m][n] = (f32x4){0.f, 0.f, 0.f, 0.f};
    bf16x8 At[4][2], B0[2][2], B1[2][2];
    const char* cA = cur.A; const char* cB = cur.B;
#if GEMM_SP2
    PG8_STAGE(PG8_SB(0, 0), cB, voffB); PG8_STAGE(PG8_SB(0, 1), cB + hB, voffB); PG8_STAGE(PG8_SA(0, 0), cA, voffA); PG8_STAGE(PG8_SA(0, 1), cA + hA, voffA);
    if (wr == 1) PG8_BAR;
    PG8_WAIT_V(2); PG8_BAR;
    PG8_STAGE(PG8_SB(1, 0), cB + kstep, voffB); PG8_STAGE(PG8_SA(1, 0), cA + kstep, voffA); PG8_STAGE(PG8_SB(1, 1), cB + hB + kstep, voffB);
    PG8_WAIT_V(6); PG8_BAR;
#else
    PG8_STAGE(PG8_SB(0, 0), cB, voffB); PG8_STAGE(PG8_SA(0, 0), cA, voffA); PG8_STAGE(PG8_SB(0, 1), cB + hB, voffB); PG8_STAGE(PG8_SA(0, 1), cA + hA, voffA);
    if (wr == 1) PG8_BAR;
    PG8_WAIT_V(4); PG8_BAR;
    PG8_STAGE(PG8_SB(1, 0), cB + kstep, voffB); PG8_STAGE(PG8_SA(1, 0), cA + kstep, voffA); PG8_STAGE(PG8_SB(1, 1), cB + hB + kstep, voffB);
    PG8_WAIT_V(6); PG8_BAR;
#endif
    for (;;) {
        const bool has_next = S.next(ui + 1, nxt);
        const char* nA = has_next ? nxt.A : cA; const char* nB = has_next ? nxt.B : cB;
        _Pragma("nounroll") for (int t = 0; t < nt; t += 2) {
            const bool last = (t == nt - 2);
            const char* a1 = cA + (size_t)(t + 1) * kstep;
            const char* a2 = last ? nA : cA + (size_t)(t + 2) * kstep; const char* b2 = last ? nB : cB + (size_t)(t + 2) * kstep;
            const char* a3 = a2 + kstep; const char* b3 = b2 + kstep;
#if GEMM_SP2
            PG8_LDB(B0, 0, 0); PG8_LDB(B1, 0, 1); PG8_SCHED; PG8_LDA(At, 0, 0); PG8_STAGE(PG8_SA(1, 1), a1 + hA, voffA);
            if (t != 0) PG8_WAIT_V(8);
            PG8_WAIT_L(0); PG8_BAR;
            if constexpr (Epi::HAS_PRE) { if (t == 0) E.pre(cur, wid, lane); }
            PG8_MMA(0, 0, At, B0); PG8_MMA(0, 1, At, B1); PG8_BAR; PG8_SCHED;
            PG8_LDA(At, 0, 1); PG8_STAGE(PG8_SB(0, 0), b2, voffB); PG8_STAGE(PG8_SB(0, 1), b2 + hB, voffB); PG8_STAGE(PG8_SA(0, 0), a2, voffA);
            PG8_WAIT_V(8); PG8_WAIT_L(0); PG8_BAR; PG8_MMA(1, 0, At, B0); PG8_MMA(1, 1, At, B1); PG8_BAR; PG8_SCHED;
            PG8_LDB(B0, 1, 0); PG8_LDB(B1, 1, 1); PG8_SCHED; PG8_LDA(At, 1, 0); PG8_STAGE(PG8_SA(0, 1), a2 + hA, voffA);
            PG8_WAIT_V(8); PG8_WAIT_L(0); PG8_BAR; PG8_MMA(0, 0, At, B0); PG8_MMA(0, 1, At, B1); PG8_BAR; PG8_SCHED;
            PG8_LDA(At, 1, 1); PG8_STAGE(PG8_SB(1, 0), b3, voffB); PG8_STAGE(PG8_SB(1, 1), b3 + hB, voffB); PG8_STAGE(PG8_SA(1, 0), a3, voffA);
            if (last) PG8_WAIT_V(6); else PG8_WAIT_V(8);
            PG8_WAIT_L(0); PG8_BAR; PG8_MMA(1, 0, At, B0); PG8_MMA(1, 1, At, B1); PG8_BAR; PG8_SCHED;
#else
            PG8_LDB(B0, 0, 0); PG8_SCHED; PG8_LDA(At, 0, 0); PG8_STAGE(PG8_SA(1, 1), a1 + hA, voffA);
            PG8_WAIT_L(8); PG8_BAR;
            if constexpr (Epi::HAS_PRE) { if (t == 0) E.pre(cur, wid, lane); }
            PG8_WAIT_L(0); PG8_MMA(0, 0, At, B0); PG8_BAR; PG8_SCHED;
            PG8_LDB(B1, 0, 1); PG8_STAGE(PG8_SB(0, 0), b2, voffB);
            PG8_BAR; PG8_WAIT_L(0); PG8_MMA(0, 1, At, B1); PG8_BAR;
            PG8_LDA(At, 0, 1); PG8_STAGE(PG8_SA(0, 0), a2, voffA);
            PG8_BAR; PG8_WAIT_L(0); PG8_MMA(1, 0, At, B0); PG8_BAR; PG8_SCHED;
            PG8_STAGE(PG8_SB(0, 1), b2 + hB, voffB);
            PG8_WAIT_V(6); PG8_BAR; PG8_MMA(1, 1, At, B1); PG8_BAR;
            PG8_LDB(B0, 1, 0); PG8_SCHED; PG8_LDA(At, 1, 0); PG8_STAGE(PG8_SA(0, 1), a2 + hA, voffA);
            PG8_WAIT_L(8); PG8_BAR; PG8_WAIT_L(0); PG8_MMA(0, 0, At, B0); PG8_BAR; PG8_SCHED;
            PG8_LDB(B1, 1, 1); PG8_STAGE(PG8_SB(1, 0), b3, voffB);
            PG8_BAR; PG8_WAIT_L(0); PG8_MMA(0, 1, At, B1); PG8_BAR;
            PG8_LDA(At, 1, 1); PG8_STAGE(PG8_SA(1, 0), a3, voffA);
            PG8_BAR; PG8_WAIT_L(0); PG8_MMA(1, 0, At, B0); PG8_BAR; PG8_SCHED;
            PG8_STAGE(PG8_SB(1, 1), b3 + hB, voffB);
            PG8_WAIT_V(6); PG8_BAR; PG8_MMA(1, 1, At, B1); PG8_BAR;
#endif
        }
        if (wr == 0) PG8_BAR;
        E(acc, cur, wr, wc, fr, fq);
        if (wr == 1) PG8_BAR;
        if (!has_next) break;
#pragma unroll
        for (int a = 0; a < 2; ++a)
#pragma unroll
            for (int b = 0; b < 2; ++b)
#pragma unroll
                for (int m = 0; m < 4; ++m)
#pragma unroll
                    for (int n = 0; n < 2; ++n) acc[a][b][m][n] = (f32x4){0.f, 0.f, 0.f, 0.f};
        cur = nxt; cA = nA; cB = nB; ++ui;
    }
    PG8_WAIT_V(0);
    if (wr == 0) PG8_BAR;
    PG8_BAR;
#undef PG8_SA
#undef PG8_SB
#undef PG8_STAGE
#undef PG8_LDA
#undef PG8_LDB
#undef PG8_MMA
#undef PG8_WAIT_V
#undef PG8_WAIT_L
#undef PG8_BAR
#undef PG8_SCHED
#endif
}

typedef f32x4 Acc[2][2][4][2];
__device__ __forceinline__ u32x4 pack8(const f32x4 a, const f32x4 b) { u32x4 w; w.x = cvt_pk_bf16(a[0], a[1]); w.y = cvt_pk_bf16(a[2], a[3]); w.z = cvt_pk_bf16(b[0], b[1]); w.w = cvt_pk_bf16(b[2], b[3]); return w; }

struct EpiIn {
    static constexpr bool PERM = true, HAS_PRE = false;
    bf16_t* U; bf16_t* PQT;
    __device__ __forceinline__ void operator()(const Acc& acc, const Unit& u, int wr, int wc, int fr, int fq) const {
#pragma unroll
        for (int ai = 0; ai < 2; ++ai)
#pragma unroll
            for (int m = 0; m < 4; ++m) {
                const int tok = u.pm * 256 + 128 * ai + 64 * wr + 16 * m + fr;
#pragma unroll
                for (int bj = 0; bj < 2; ++bj) {
                    if (u.pn < 2) {
                        const int c = 256 * u.pn + 128 * bj + 32 * wc + 8 * fq, g = c >> 4, h0 = c & 15;
                        *(u32x4*)(U + ((size_t)(g * 1024 + (tok >> 5))) * UK + (tok & 31) * 16 + h0) = pack8(acc[ai][bj][m][0], acc[ai][bj][m][1]);
                    } else {
                        const int b = tok >> 11, l = tok & 2047;
#pragma unroll
                        for (int n = 0; n < 2; ++n)
#pragma unroll
                            for (int e = 0; e < 4; ++e) {
                                const int cc = 256 * (u.pn - 2) + 128 * bj + 32 * wc + 8 * fq + 4 * n + e, h = cc >> 7, r = cc & 127, bh = b * 4 + h;
                                const size_t row = (r < 64) ? (size_t)(bh * 64 + r) : (r == 64) ? (size_t)(4096 + bh) : (size_t)(4352 + bh * 64 + (r - 64));
                                PQT[row * 2048 + l] = f2bf(acc[ai][bj][m][n][e]);
                            }
                    }
                }
            }
    }
};
struct EpiSloc {
    static constexpr bool PERM = false, HAS_PRE = false;
    float* S;
    __device__ __forceinline__ void operator()(const Acc& acc, const Unit& u, int wr, int wc, int fr, int fq) const {
#pragma unroll
        for (int ai = 0; ai < 2; ++ai)
#pragma unroll
            for (int m = 0; m < 4; ++m) {
                float* rp = S + ((size_t)(u.aux * 1024 + u.pm * 256 + 128 * ai + 64 * wr + 16 * m + fr)) * 256 + 32 * wc + 4 * fq;
#pragma unroll
                for (int bj = 0; bj < 2; ++bj)
#pragma unroll
                    for (int n = 0; n < 2; ++n) *(f32x4*)(rp + 128 * bj + 16 * n) = acc[ai][bj][m][n];
            }
    }
};
struct EpiDft {
    static constexpr bool PERM = true, HAS_PRE = false;
    bf16_t* EO;
    __device__ __forceinline__ void operator()(const Acc& acc, const Unit& u, int wr, int wc, int fr, int fq) const {
#pragma unroll
        for (int ai = 0; ai < 2; ++ai)
#pragma unroll
            for (int m = 0; m < 4; ++m) {
                const int k = u.pm * 256 + 128 * ai + 64 * wr + 16 * m + fr;
#pragma unroll
                for (int bj = 0; bj < 2; ++bj) {
                    const int n = 256 * u.pn + 128 * bj + 32 * wc + 8 * fq;
                    *(u32x4*)(EO + ((size_t)(u.aux * 1024 + k)) * 4352 + n) = pack8(acc[ai][bj][m][0], acc[ai][bj][m][1]);
                }
            }
    }
};
struct EpiY {
    static constexpr bool PERM = true, HAS_PRE = false;
    bf16_t* Z;
    __device__ __forceinline__ void operator()(const Acc& acc, const Unit& u, int wr, int wc, int fr, int fq) const {
#pragma unroll
        for (int ai = 0; ai < 2; ++ai)
#pragma unroll
            for (int m = 0; m < 4; ++m) {
                const int R = u.pm * 256 + 128 * ai + 64 * wr + 16 * m + fr;
#pragma unroll
                for (int bj = 0; bj < 2; ++bj) {
                    const int c = 256 * u.pn + 128 * bj + 32 * wc + 8 * fq, t = c >> 4, h0 = c & 15;
                    f32x4 a = acc[ai][bj][m][0], b = acc[ai][bj][m][1];
                    { const f32x2 g0 = gelu_t2((f32x2){a[0], a[1]}), g1 = gelu_t2((f32x2){a[2], a[3]}), g2 = gelu_t2((f32x2){b[0], b[1]}), g3 = gelu_t2((f32x2){b[2], b[3]});
                      a = (f32x4){g0[0], g0[1], g1[0], g1[1]}; b = (f32x4){g2[0], g2[1], g3[0], g3[1]}; }
                    *(u32x4*)(Z + ((size_t)(R * 32 + t)) * 512 + u.aux * 16 + h0) = pack8(a, b);
                }
            }
    }
};
struct EpiGlu {
    static constexpr bool PERM = true, HAS_PRE = false;
    const bf16_t* Z; const float* bias; bf16_t* cat;
    __device__ __forceinline__ void operator()(const Acc& acc, const Unit& u, int wr, int wc, int fr, int fq) const {
        const int c0 = 256 * u.pn + 32 * wc + 8 * fq, tok0 = u.pm * 256 + 64 * wr + fr;
        f32x4 bv[2][2];
#pragma unroll
        for (int bj = 0; bj < 2; ++bj) { bv[bj][0] = *(const f32x4*)(bias + c0 + 128 * bj); bv[bj][1] = *(const f32x4*)(bias + c0 + 128 * bj + 4); }
#pragma unroll
        for (int ai = 0; ai < 2; ++ai) {
            u32x4 zz[4][2];
#pragma unroll
            for (int m = 0; m < 4; ++m)
#pragma unroll
                for (int bj = 0; bj < 2; ++bj) zz[m][bj] = *(const u32x4*)(Z + (size_t)(tok0 + 128 * ai + 16 * m) * 512 + c0 + 128 * bj);
#pragma unroll
            for (int m = 0; m < 4; ++m)
#pragma unroll
                for (int bj = 0; bj < 2; ++bj) {
                    const u32x4 z = zz[m][bj];
                    f32x4 a = acc[ai][bj][m][0] + bv[bj][0], b = acc[ai][bj][m][1] + bv[bj][1];
                    a[0] = bflo(z.x) * sigmoid_f(a[0]); a[1] = bfhi(z.x) * sigmoid_f(a[1]); a[2] = bflo(z.y) * sigmoid_f(a[2]); a[3] = bfhi(z.y) * sigmoid_f(a[3]);
                    b[0] = bflo(z.z) * sigmoid_f(b[0]); b[1] = bfhi(z.z) * sigmoid_f(b[1]); b[2] = bflo(z.w) * sigmoid_f(b[2]); b[3] = bfhi(z.w) * sigmoid_f(b[3]);
                    *(u32x4*)(cat + (size_t)(tok0 + 128 * ai + 16 * m) * 1024 + c0 + 128 * bj) = pack8(a, b);
                }
        }
    }
};
template <bool BASE_BF> struct EpiRes {
    static constexpr bool PERM = true, HAS_PRE = false;
    const void* base; bf16_t* H; float* ss; LAS float* RED;
    __device__ __forceinline__ void operator()(const Acc& acc, const Unit& u, int wr, int wc, int fr, int fq) const {
        const int c0 = 256 * u.pn + 32 * wc + 8 * fq, tok0 = u.pm * 256 + 64 * wr + fr;
        float sarr[8];
#pragma unroll
        for (int ai = 0; ai < 2; ++ai) {
            f32x4 bv[4][2][2]; u32x4 bz[4][2];
#pragma unroll
            for (int m = 0; m < 4; ++m)
#pragma unroll
                for (int bj = 0; bj < 2; ++bj) { const size_t o = (size_t)(tok0 + 128 * ai + 16 * m) * 1024 + c0 + 128 * bj;
                    if (BASE_BF) bz[m][bj] = *(const u32x4*)((const bf16_t*)base + o);
                    else { bv[m][bj][0] = *(const f32x4*)((const float*)base + o); bv[m][bj][1] = *(const f32x4*)((const float*)base + o + 4); } }
#pragma unroll
            for (int m = 0; m < 4; ++m) {
                float s = 0.f;
#pragma unroll
                for (int bj = 0; bj < 2; ++bj) {
                    const size_t o = (size_t)(tok0 + 128 * ai + 16 * m) * 1024 + c0 + 128 * bj;
                    f32x4 a, b;
                    if (BASE_BF) { const u32x4 z = bz[m][bj]; a = acc[ai][bj][m][0] + (f32x4){bflo(z.x), bfhi(z.x), bflo(z.y), bfhi(z.y)}; b = acc[ai][bj][m][1] + (f32x4){bflo(z.z), bfhi(z.z), bflo(z.w), bfhi(z.w)}; }
                    else { a = acc[ai][bj][m][0] + bv[m][bj][0]; b = acc[ai][bj][m][1] + bv[m][bj][1]; }
                    *(u32x4*)(H + o) = pack8(a, b);
                    s += (a[0] * a[0] + a[1] * a[1]) + (a[2] * a[2] + a[3] * a[3]) + (b[0] * b[0] + b[1] * b[1]) + (b[2] * b[2] + b[3] * b[3]);
                }
                s += __shfl_xor(s, 16); s += __shfl_xor(s, 32);
                sarr[ai * 4 + m] = s;
            }
        }
        if (fq == 0) {
#pragma unroll
            for (int i = 0; i < 8; ++i) RED[(64 * wr + fr + 128 * (i >> 2) + 16 * (i & 3)) * 4 + wc] = sarr[i];
        }
        asm volatile("s_waitcnt lgkmcnt(0)" ::: "memory"); __builtin_amdgcn_s_barrier(); asm volatile("" ::: "memory");
        const int tid = (wr * 4 + wc) * 64 + fq * 16 + fr;
        if (tid < 256) { const f32x4 r = *(const LAS f32x4*)(RED + tid * 4); ss[(size_t)(u.pm * 256 + tid) * 4 + u.pn] = (r[0] + r[1]) + (r[2] + r[3]); }
    }
};
struct EpiFinal {
    static constexpr bool PERM = true, HAS_PRE = false;
    const bf16_t* base; float* out; const float* gfin; float* xs; unsigned* cnt; LAS float* RED;
    __device__ __forceinline__ void operator()(const Acc& acc_in, const Unit& u, int wr, int wc, int fr, int fq) const {
        Acc& acc = const_cast<Acc&>(acc_in);
        const int c0 = 256 * u.pn + 32 * wc + 8 * fq, tok0 = u.pm * 256 + 64 * wr + fr, tid = (wr * 4 + wc) * 64 + fq * 16 + fr;
        float sarr[8];
#pragma unroll
        for (int ai = 0; ai < 2; ++ai) {
            u32x4 bz[4][2];
#pragma unroll
            for (int m = 0; m < 4; ++m)
#pragma unroll
                for (int bj = 0; bj < 2; ++bj) bz[m][bj] = *(const u32x4*)(base + (size_t)(tok0 + 128 * ai + 16 * m) * 1024 + c0 + 128 * bj);
#pragma unroll
            for (int m = 0; m < 4; ++m) {
                float s = 0.f;
#pragma unroll
                for (int bj = 0; bj < 2; ++bj) {
                    const u32x4 z = bz[m][bj];
                    const f32x4 a = acc[ai][bj][m][0] + (f32x4){bflo(z.x), bfhi(z.x), bflo(z.y), bfhi(z.y)}, b = acc[ai][bj][m][1] + (f32x4){bflo(z.z), bfhi(z.z), bflo(z.w), bfhi(z.w)};
                    acc[ai][bj][m][0] = a; acc[ai][bj][m][1] = b;
                    s += (a[0] * a[0] + a[1] * a[1]) + (a[2] * a[2] + a[3] * a[3]) + (b[0] * b[0] + b[1] * b[1]) + (b[2] * b[2] + b[3] * b[3]);
                }
                s += __shfl_xor(s, 16); s += __shfl_xor(s, 32);
                sarr[ai * 4 + m] = s;
            }
        }
        if (fq == 0) {
#pragma unroll
            for (int i = 0; i < 8; ++i) RED[(64 * wr + fr + 128 * (i >> 2) + 16 * (i & 3)) * 4 + wc] = sarr[i];
        }
        asm volatile("s_waitcnt lgkmcnt(0)" ::: "memory"); __builtin_amdgcn_s_barrier(); asm volatile("" ::: "memory");
        if (tid < 256) { const f32x4 r = *(const LAS f32x4*)(RED + tid * 4); xs[(size_t)(u.pm * 256 + tid) * 4 + u.pn] = (r[0] + r[1]) + (r[2] + r[3]); }
        asm volatile("s_waitcnt vmcnt(0)" ::: "memory"); __builtin_amdgcn_s_barrier(); asm volatile("" ::: "memory");
        if (tid == 0) {
            unsigned* c = cnt + (size_t)u.pm * 64;
            __builtin_amdgcn_fence(__ATOMIC_RELEASE, "agent");
            asm volatile("s_waitcnt vmcnt(0)" ::: "memory");
            (void)__hip_atomic_fetch_add(c, 1u, __ATOMIC_RELAXED, __HIP_MEMORY_SCOPE_AGENT);
            unsigned sp = 0u;
            while (__hip_atomic_load(c, __ATOMIC_RELAXED, __HIP_MEMORY_SCOPE_AGENT) < 4u) { __builtin_amdgcn_s_sleep(1); if (++sp > (1u << 22)) break; }
            __builtin_amdgcn_fence(__ATOMIC_ACQUIRE, "agent");
            asm volatile("s_waitcnt vmcnt(0)" ::: "memory");
        }
        __builtin_amdgcn_s_barrier(); asm volatile("" ::: "memory");
        if (tid < 256) { const f32x4 p = *(const f32x4*)(xs + (size_t)(u.pm * 256 + tid) * 4); RED[1024 + tid] = rsqrtf(((p[0] + p[1]) + (p[2] + p[3])) * (1.0f / DM) + EPS); }
        asm volatile("s_waitcnt lgkmcnt(0)" ::: "memory"); __builtin_amdgcn_s_barrier(); asm volatile("" ::: "memory");
        f32x4 gv[2][2];
#pragma unroll
        for (int bj = 0; bj < 2; ++bj) { gv[bj][0] = *(const f32x4*)(gfin + c0 + 128 * bj); gv[bj][1] = *(const f32x4*)(gfin + c0 + 128 * bj + 4); }
#pragma unroll
        for (int ai = 0; ai < 2; ++ai)
#pragma unroll
            for (int m = 0; m < 4; ++m) {
                const float rs = RED[1024 + 64 * wr + fr + 128 * ai + 16 * m];
#pragma unroll
                for (int bj = 0; bj < 2; ++bj) { float* op = out + (size_t)(tok0 + 128 * ai + 16 * m) * 1024 + c0 + 128 * bj;
                    *(f32x4*)op = acc[ai][bj][m][0] * rs * gv[bj][0]; *(f32x4*)(op + 4) = acc[ai][bj][m][1] * rs * gv[bj][1]; }
            }
    }
};
struct EpiUp {
    static constexpr bool PERM = true, HAS_PRE = true;
    __device__ __forceinline__ void pre(const Unit& u, int wid, int lane) const {
        if (wid < 4) {
            const int t = wid * 64 + lane, k = t >> 6, c = (t & 63) * 4, col = (c >> 7) * DFF + u.pn * 128 + (c & 127);
            const float* src = (k < 3) ? cw + (size_t)k * NUP + col : cb + col;
            __builtin_amdgcn_global_load_lds((const unsigned*)src, (LAS unsigned*)(X + 2048 + wid * 256), 16, 0, 0);
            __builtin_amdgcn_global_load_lds((const unsigned*)(ss + (size_t)(u.pm * 256 + t) * 4), (LAS unsigned*)(X + 3072 + wid * 256), 16, 0, 0);
        }
    }
    const float* ss; const float* cw; const float* cb; bf16_t* act; float* EB; LAS float* X;
    __device__ __forceinline__ void operator()(const Acc& acc_in, const Unit& u, int wr, int wc, int fr_, int fq_) const {
        Acc& acc = const_cast<Acc&>(acc_in);
        int lane = threadIdx.x & 63; asm volatile("" : "+v"(lane));
        const int fr = lane & 15, fq = lane >> 4, tid = (wr * 4 + wc) * 64 + lane;
        const int cl = 32 * wc + 8 * fq;
        LAS float* CST = X + 2048; LAS float* RSP = X + 3072; LAS float* RS = X + 4096;
        if (tid < 256) { const f32x4 r = *(const LAS f32x4*)(RSP + tid * 4); RS[tid] = rsqrtf(((r[0] + r[1]) + (r[2] + r[3])) * (1.0f / DM) + EPS); }
#pragma unroll
        for (int ai = 0; ai < 2; ++ai) {
            const int q = 2 * ai + wr;
#pragma unroll
            for (int bj = 0; bj < 2; ++bj)
#pragma unroll
                for (int n = 0; n < 2; ++n) {
                    const bool f0 = (fr == 0), f15 = (fr == 15);
                    f32x4 lo = acc[ai][bj][0][n], hi = acc[ai][bj][3][n], sv;
#pragma unroll
                    for (int e = 0; e < 4; ++e) sv[e] = f0 ? lo[e] : hi[e];
                    if (f0 || f15) *(LAS f32x4*)(X + (q * 2 + (f0 ? 0 : 1)) * 256 + 128 * bj + cl + 4 * n) = sv;
                }
        }
        asm volatile("s_waitcnt lgkmcnt(0)" ::: "memory");
        __builtin_amdgcn_s_barrier();
        asm volatile("" ::: "memory");
#pragma unroll
        for (int ai = 0; ai < 2; ++ai) {
            const int q = 2 * ai + wr;
#pragma unroll
            for (int m = 0; m < 4; ++m) {
                const float rs = RS[128 * ai + 64 * wr + 16 * m + fr];
#pragma unroll
                for (int bj = 0; bj < 2; ++bj)
#pragma unroll
                    for (int n = 0; n < 2; ++n) acc[ai][bj][m][n] = acc[ai][bj][m][n] * rs;
            }
#pragma unroll
            for (int bj = 0; bj < 2; ++bj)
#pragma unroll
                for (int n = 0; n < 2; ++n) {
                    const bool e0 = (q == 0 && fr < 2), e3 = (q == 3 && fr >= 14);
                    f32x4 lo = acc[ai][bj][0][n], hi = acc[ai][bj][3][n], ev;
#pragma unroll
                    for (int e = 0; e < 4; ++e) ev[e] = e0 ? lo[e] : hi[e];
                    const size_t ec = (size_t)bj * DFF + u.pn * 128 + cl + 4 * n;
                    if (e0 || e3) *(f32x4*)(EB + ((size_t)(u.pm * 4 + (e0 ? fr : fr - 12))) * NUP + ec) = ev;
                }
        }
#pragma unroll
        for (int n = 0; n < 2; ++n)
#pragma unroll
            for (int ep = 0; ep < 2; ++ep) {
                const int ci = cl + 4 * n + 2 * ep;
                if (ep == 0 && n == 0) __builtin_amdgcn_sched_barrier(0);
                f32x2 w0[2], w1[2], w2[2], bb[2];
#pragma unroll
                for (int bj = 0; bj < 2; ++bj) { w0[bj] = *(const LAS f32x2*)(CST + 128 * bj + ci); w1[bj] = *(const LAS f32x2*)(CST + 256 + 128 * bj + ci); w2[bj] = *(const LAS f32x2*)(CST + 512 + 128 * bj + ci); bb[bj] = *(const LAS f32x2*)(CST + 768 + 128 * bj + ci); }
#pragma unroll
                for (int ai = 0; ai < 2; ++ai) {
                    const int q = 2 * ai + wr;
                    f32x2 cv[2][4];
#pragma unroll
                    for (int bj = 0; bj < 2; ++bj) {
                        f32x2 top = *(const LAS f32x2*)(X + ((q > 0 ? q - 1 : 0) * 2 + 1) * 256 + 128 * bj + ci) * RS[q > 0 ? 64 * q - 1 : 0]; if (q == 0) top = (f32x2){0.f, 0.f};
                        f32x2 bot = *(const LAS f32x2*)(X + ((q < 3 ? q + 1 : 3) * 2 + 0) * 256 + 128 * bj + ci) * RS[q < 3 ? 64 * q + 64 : 255]; if (q == 3) bot = (f32x2){0.f, 0.f};
                        f32x2 v[4];
#pragma unroll
                        for (int m = 0; m < 4; ++m) v[m] = (f32x2){acc[ai][bj][m][n][2 * ep], acc[ai][bj][m][n][2 * ep + 1]};
#pragma unroll
                        for (int m = 0; m < 4; ++m) {
                            f32x2 pv, nv;
#pragma unroll
                            for (int c = 0; c < 2; ++c) {
                                const float po = (m == 0) ? top[c] : dpp_rot<0x121>(v[m > 0 ? m - 1 : 0][c]);
                                pv[c] = dpp_upd<0x111>(po, v[m][c]);
                                const float no = (m == 3) ? bot[c] : dpp_rot<0x12f>(v[m < 3 ? m + 1 : 3][c]);
                                nv[c] = dpp_upd<0x101>(no, v[m][c]);
                            }
                            cv[bj][m] = bb[bj] + w0[bj] * pv + w1[bj] * v[m] + w2[bj] * nv;
                        }
                    }
#pragma unroll
                    for (int m = 0; m < 4; ++m) { const f32x2 r = gelu_t2(cv[0][m]) * cv[1][m]; acc[ai][0][m][n][2 * ep] = r[0]; acc[ai][0][m][n][2 * ep + 1] = r[1]; }
                }
            }
#pragma unroll
        for (int ai = 0; ai < 2; ++ai)
#pragma unroll
            for (int m = 0; m < 4; ++m) {
                const int tok = u.pm * 256 + 128 * ai + 64 * wr + 16 * m + fr;
                *(u32x4*)(act + (size_t)tok * DFF + u.pn * 128 + cl) = pack8(acc[ai][0][m][0], acc[ai][0][m][1]);
            }
    }
};

__device__ __forceinline__ void s5_lam(const Params& P, int dir, int g, int p, float& ar, float& ai, float& lr, float& li) {
    const float dt = expf(P.log_dt[dir * 32 + g]); const int i = (dir * 32 + g) * 64 + p; lr = P.lam_re[i]; li = P.lam_im[i]; ar = lr * dt; ai = li * dt;
}
__device__ __forceinline__ void cpowf_(float ar, float ai, float e, float& re, float& im) { const float mg = expf(ar * e); float s, c; sincosf(ai * e, &s, &c); re = mg * c; im = mg * s; }
__device__ __forceinline__ void s5_coef(float ar, float ai, float lr, float li, float& cr, float& ci) {
    float s, c; sincosf(ai, &s, &c); const float em1 = expm1f(ar), sh = sinf(0.5f * ai);
    const float nr = em1 * c - 2.0f * sh * sh, ni = (em1 + 1.0f) * s, den = lr * lr + li * li;
    cr = (nr * lr + ni * li) / den; ci = (ni * lr - nr * li) / den;
}

__device__ __forceinline__ void p0_transposes(const Params& P, unsigned char* shm, const int tid, const int bid, const int gsz, const int sel) {
    unsigned char* ws = P.ws;
    bf16_t* WinT = (bf16_t*)(ws + O_WIN); bf16_t* WgluT = (bf16_t*)(ws + O_WGLU); bf16_t* WoutT = (bf16_t*)(ws + O_WOUT); bf16_t* WupT = (bf16_t*)(ws + O_WUP); bf16_t* WdnT = (bf16_t*)(ws + O_WDN);
    {
        float* tile = (float*)shm;
        constexpr int T0 = 16 * 8, T1 = 8 * 8, T2 = 8 * 16, T3 = 16 * 88, T4 = 44 * 16; const int TT = (sel == 1) ? T1 + T2 + T4 : (sel >= 2) ? T3 / 2 : T0;
        auto decode = [&](int vt, const float*& src, int& lds_, bf16_t*& dst, int& ldd, int& k0, int& n0, int& sn0, int& mode) {
            int r = (sel == 1) ? (vt < T1 + T2 ? T0 + vt : vt + T0 + T3) : (sel >= 2) ? vt + T0 + T1 + T2 + (sel == 3 ? T3 / 2 : 0) : vt, nkt; mode = 0;
            if (r < T0) { src = P.w_in; lds_ = 1024; dst = WinT; ldd = 1024; nkt = 16; }
            else if ((r -= T0) < T1) { src = P.w_glu; lds_ = 512; dst = WgluT; ldd = 512; nkt = 8; }
            else if ((r -= T1) < T2) { src = P.w_out; lds_ = 1024; dst = WoutT; ldd = 1024; nkt = 8; }
            else if ((r -= T2) < T3) { src = P.w_up; lds_ = NUP; dst = WupT; ldd = 1024; nkt = 16; mode = 1; }
            else { r -= T3; src = P.w_down; lds_ = 1024; dst = WdnT; ldd = DFF; nkt = 44; }
            k0 = (r % nkt) * 64; n0 = (r / nkt) * 64;
            sn0 = n0; if (mode == 1) { const int pn = n0 >> 8, bj = (n0 >> 7) & 1, r0 = n0 & 127; sn0 = bj * DFF + pn * 128 + r0; }
        };
        const int rr0 = tid >> 4, c4 = (tid & 15) * 4;
        f32x4 pv[2];
        { int it = bid; if (it < TT) { const float* src; int lds_, ldd, k0, n0, sn0, mode; bf16_t* dst; decode(it, src, lds_, dst, ldd, k0, n0, sn0, mode);
#pragma unroll
            for (int i = 0; i < 2; ++i) { pv[i] = *(const f32x4*)(src + (size_t)(k0 + rr0 + 32 * i) * lds_ + sn0 + c4); if (mode == 1) pv[i] = pv[i] * P.g_ffn[k0 + rr0 + 32 * i]; } } }
        for (int it = bid; it < TT; it += gsz) {
            const float* src; int lds_, ldd, k0, n0, sn0, mode; bf16_t* dst; decode(it, src, lds_, dst, ldd, k0, n0, sn0, mode);
            __syncthreads();
#pragma unroll
            for (int i = 0; i < 2; ++i) { const int rr = rr0 + 32 * i; tile[rr * 65 + c4] = pv[i][0]; tile[rr * 65 + c4 + 1] = pv[i][1]; tile[rr * 65 + c4 + 2] = pv[i][2]; tile[rr * 65 + c4 + 3] = pv[i][3]; }
            __syncthreads();
            if (it + gsz < TT) { const float* src2; int lds2, ldd2, k02, n02, sn02, mode2; bf16_t* dst2; decode(it + gsz, src2, lds2, dst2, ldd2, k02, n02, sn02, mode2);
#pragma unroll
                for (int i = 0; i < 2; ++i) { pv[i] = *(const f32x4*)(src2 + (size_t)(k02 + rr0 + 32 * i) * lds2 + sn02 + c4); if (mode2 == 1) pv[i] = pv[i] * P.g_ffn[k02 + rr0 + 32 * i]; } }
            { const int nl = tid >> 3, kc = (tid & 7) * 8; const float* tp = tile + kc * 65 + nl;
                u32x4 w; w.x = cvt_pk_bf16(tp[0], tp[65]); w.y = cvt_pk_bf16(tp[2 * 65], tp[3 * 65]); w.z = cvt_pk_bf16(tp[4 * 65], tp[5 * 65]); w.w = cvt_pk_bf16(tp[6 * 65], tp[7 * 65]);
                *(u32x4*)(dst + (size_t)(n0 + nl) * ldd + k0 + kc) = w; }
        }
        __syncthreads();
    }
}
__device__ __forceinline__ void p0_c2(const Params& P, unsigned char* shm, const int tid, const int bid, const int gsz) {
    bf16_t* WoutT = (bf16_t*)(P.ws + O_WOUT);
    {
        float* wo = (float*)shm; float* wfT = wo + 128 * 64;
        for (int it = bid; it < 64; it += gsz) {
            const int h = it >> 4, n0 = (it & 15) * 64;
            __syncthreads();
            for (int i = 0; i < 4; ++i) { const int idx = (tid + 512 * i) * 4, d = idx >> 6, n = idx & 63; *(f32x4*)(wo + idx) = *(const f32x4*)(P.w_out + (size_t)(512 + h * 128 + d) * 1024 + n0 + n); }
            for (int i = 0; i < 32; ++i) { const int idx = tid + 512 * i, d = idx >> 7, c = idx & 127; wfT[idx] = P.w_fourier[(size_t)(h * 128 + c) * 128 + d]; }
            __syncthreads();
            const int c0 = (tid & 31) * 4, nn = (tid >> 5) * 4; f32x4 a[4];
#pragma unroll
            for (int i = 0; i < 4; ++i) a[i] = (f32x4){0.f, 0.f, 0.f, 0.f};
            for (int d = 0; d < 128; ++d) { const f32x4 f = *(const f32x4*)(wfT + d * 128 + c0), w = *(const f32x4*)(wo + d * 64 + nn);
#pragma unroll
                for (int i = 0; i < 4; ++i) a[i] += w[i] * f; }
#pragma unroll
            for (int i = 0; i < 4; ++i) { u32x2 w; w.x = cvt_pk_bf16(a[i][0], a[i][1]); w.y = cvt_pk_bf16(a[i][2], a[i][3]); *(u32x2*)(WoutT + (size_t)(n0 + nn + i) * 1024 + 512 + h * 128 + c0) = w; }
        }
        __syncthreads();
    }
}

__device__ __forceinline__ void phase0(const Params& P, unsigned char* shm, const int bid, const int gsz) {
    unsigned char* ws = P.ws;
    int tid_ = threadIdx.x; asm volatile("" : "+v"(tid_));
    const int tid = tid_, wid = tid >> 6, lane = tid & 63;
    const int gtid = bid * 512 + tid, nthr = gsz * 512;
    bf16_t* WinT = (bf16_t*)(ws + O_WIN); bf16_t* WgluT = (bf16_t*)(ws + O_WGLU); bf16_t* WoutT = (bf16_t*)(ws + O_WOUT); bf16_t* WupT = (bf16_t*)(ws + O_WUP); bf16_t* WdnT = (bf16_t*)(ws + O_WDN);
    auto rmsnorm_rows = [&]()     {
        bf16_t* xn = (bf16_t*)(ws + O_XN);
        f32x4 gm[4];
#pragma unroll
        for (int i = 0; i < 4; ++i) gm[i] = ((const f32x4*)P.g_mix)[lane + 64 * i];
        for (int row0 = (bid * 8 + wid) * 4; row0 < NTOK; row0 += gsz * 8 * 4) {
            f32x4 v[4][4];
#pragma unroll
            for (int r = 0; r < 4; ++r)
#pragma unroll
                for (int i = 0; i < 4; ++i) v[r][i] = ((const f32x4*)(P.x + (size_t)(row0 + r) * DM))[lane + 64 * i];
#pragma unroll
            for (int r = 0; r < 4; ++r) {
                float s = 0.f;
#pragma unroll
                for (int i = 0; i < 4; ++i) s += (v[r][i][0] * v[r][i][0] + v[r][i][1] * v[r][i][1]) + (v[r][i][2] * v[r][i][2] + v[r][i][3] * v[r][i][3]);
#pragma unroll
                for (int o = 32; o; o >>= 1) s += __shfl_xor(s, o);
                const float rs = rsqrtf(s * (1.0f / DM) + EPS);
#pragma unroll
                for (int i = 0; i < 4; ++i) { const f32x4 t = v[r][i] * rs * gm[i]; u32x2 w; w.x = cvt_pk_bf16(t[0], t[1]); w.y = cvt_pk_bf16(t[2], t[3]);
                    *(u32x2*)(xn + (size_t)(row0 + r) * DM + (lane + 64 * i) * 4) = w; }
            }
        }
    };
    if (bid & 1) rmsnorm_rows();
    p0_transposes(P, shm, tid, bid, gsz, 0);
    {
        float* wt = (float*)shm; float* cs = wt + 16 * 128; float* sn = cs + 128;
        for (int it = bid; it < 256; it += gsz) {
            const int h = it >> 6, k0 = (it & 63) * 16;
            __syncthreads();
            if (tid < 128) { float s, c; sincospif((float)tid * (1.0f / 64.0f), &s, &c); cs[tid] = c * 0.08838834764831845f; sn[tid] = s * 0.08838834764831845f; }
            { const int row = tid >> 5, c4 = tid & 31; *(f32x4*)(wt + row * 128 + c4 * 4) = *(const f32x4*)(P.w_in + (size_t)(k0 + row) * 1024 + 512 + h * 128 + c4 * 4); }
            __syncthreads();
            const int r = tid & 127, ks = tid >> 7, j = (r <= 64) ? r : r - 64; const float* tb = (r <= 64) ? cs : sn;
            float a[4];
#pragma unroll
            for (int kk = 0; kk < 4; ++kk) a[kk] = 0.f;
            for (int c = 0; c < 128; c += 4) { const float t0 = tb[(c * j) & 127], t1 = tb[((c + 1) * j) & 127], t2 = tb[((c + 2) * j) & 127], t3 = tb[((c + 3) * j) & 127];
#pragma unroll
                for (int kk = 0; kk < 4; ++kk) { const f32x4 w4 = *(const f32x4*)(wt + (ks * 4 + kk) * 128 + c); a[kk] += (w4[0] * t0 + w4[1] * t1) + (w4[2] * t2 + w4[3] * t3); } }
            u32x2 w; w.x = cvt_pk_bf16(a[0], a[1]); w.y = cvt_pk_bf16(a[2], a[3]);
            *(u32x2*)(WinT + (size_t)(512 + h * 128 + r) * 1024 + k0 + ks * 4) = w;
        }
        __syncthreads();
    }
    {
        bf16_t* AL = (bf16_t*)(ws + O_AL); float* tab = (float*)shm;
        __syncthreads();
        for (int i = tid; i < 2048; i += 512) tab[i] = cospif((float)i * (1.0f / 1024.0f)) * 0.02209708691207961f;
        __syncthreads();
        for (int it = gtid; it < (1 << 19); it += nthr) {
            const int l8 = (it & 255) * 8, k = (it >> 8) & 1023, sc = it >> 18; float v[8];
#pragma unroll
            for (int e = 0; e < 8; ++e) v[e] = tab[(k * (l8 + e) - (sc ? 512 : 0)) & 2047];
            u32x4 w; w.x = cvt_pk_bf16(v[0], v[1]); w.y = cvt_pk_bf16(v[2], v[3]); w.z = cvt_pk_bf16(v[4], v[5]); w.w = cvt_pk_bf16(v[6], v[7]);
            *(u32x4*)(AL + ((size_t)(sc * 1024 + k)) * 2048 + l8) = w;
        }
        __syncthreads();
    }
    {
        bf16_t* Wst = (bf16_t*)(ws + O_WST); bf16_t* Wy = (bf16_t*)(ws + O_WY); float* Kt = (float*)(ws + O_KTAB);
        float* Lr = (float*)shm; float* Li = Lr + 33 * 64; float* Fr = Li + 33 * 64; float* Fi = Fr + 64; float* Cr = Fi + 64; float* Ci = Cr + 1024; float* Br = Ci + 1024; float* Bi = Br + 1024;
        for (int it = bid; it < 256; it += gsz) {
            const int qt = it & 3, dir = (it >> 2) & 1, g = it >> 3;
            __syncthreads();
            { const int p = tid & 63, dl = tid >> 6; float ar, ai, lr, li; s5_lam(P, dir, g, p, ar, ai, lr, li);
              for (int e = dl; e < 33; e += 8) { float pr, pi; cpowf_(ar, ai, (float)e, pr, pi); Lr[e * 64 + p] = pr; Li[e * 64 + p] = pi; }
              if (dl == 0) { float cr, ci; s5_coef(ar, ai, lr, li, cr, ci); Fr[p] = cr; Fi[p] = ci; }
              const size_t cb0 = (size_t)(dir * 32 + g) * 1024;
#pragma unroll
              for (int i = 0; i < 2; ++i) { const int idx = tid + 512 * i; Cr[idx] = P.c_re[cb0 + idx]; Ci[idx] = P.c_im[cb0 + idx]; Br[idx] = P.b_re[cb0 + idx]; Bi[idx] = P.b_im[cb0 + idx]; } }
            __syncthreads();
#pragma unroll
            for (int j = 0; j < 2; ++j) {
                const int idx = tid + 512 * j, sl = idx & 7, rowi = idx >> 3, part = rowi >> 6, p = rowi & 63, s = qt * 8 + sl, e = dir ? s : 31 - s;
                const float Er = Lr[e * 64 + p] * Fr[p] - Li[e * 64 + p] * Fi[p], Ei = Lr[e * 64 + p] * Fi[p] + Li[e * 64 + p] * Fr[p];
                float o[16];
#pragma unroll
                for (int h = 0; h < 16; ++h) o[h] = part ? (Er * Bi[p * 16 + h] + Ei * Br[p * 16 + h]) : (Er * Br[p * 16 + h] - Ei * Bi[p * 16 + h]);
                u32x4 w0, w1; w0.x = cvt_pk_bf16(o[0], o[1]); w0.y = cvt_pk_bf16(o[2], o[3]); w0.z = cvt_pk_bf16(o[4], o[5]); w0.w = cvt_pk_bf16(o[6], o[7]);
                w1.x = cvt_pk_bf16(o[8], o[9]); w1.y = cvt_pk_bf16(o[10], o[11]); w1.z = cvt_pk_bf16(o[12], o[13]); w1.w = cvt_pk_bf16(o[14], o[15]);
                u32x4* d = (u32x4*)(Wst + ((size_t)(g * 256 + dir * 128 + rowi)) * 512 + s * 16); d[0] = w0; d[1] = w1;
            }
            { const int p = tid & 63, t = qt * 8 + (tid >> 6), e = dir ? 32 - t : t + 1; const float pr = Lr[e * 64 + p], pi = Li[e * 64 + p];
#pragma unroll
              for (int h = 0; h < 16; ++h) { const float cr = Cr[h * 64 + p], ci = Ci[h * 64 + p]; bf16_t* d = Wy + ((size_t)(g * 512 + t * 16 + h)) * UK + 512 + dir * 128 + p;
                  d[0] = f2bf(cr * pr - ci * pi); d[64] = f2bf(-(cr * pi + ci * pr)); } }
            { const int o = tid & 255, h = o >> 4, h2 = o & 15, dh = tid >> 8; float a[4] = {0.f, 0.f, 0.f, 0.f};
              for (int p = 0; p < 64; ++p) {
                  const float cr = Cr[h * 64 + p], ci = Ci[h * 64 + p], xr = cr * Fr[p] - ci * Fi[p], xi = cr * Fi[p] + ci * Fr[p];
                  const float br = Br[p * 16 + h2], bi = Bi[p * 16 + h2], mr = xr * br - xi * bi, mi = xr * bi + xi * br;
#pragma unroll
                  for (int j = 0; j < 4; ++j) { const int d = qt * 8 + dh * 4 + j; a[j] += mr * Lr[d * 64 + p] - mi * Li[d * 64 + p]; }
              }
#pragma unroll
              for (int j = 0; j < 4; ++j) Kt[((size_t)((g * 2 + dir) * 32 + qt * 8 + dh * 4 + j)) * 256 + o] = a[j]; }
        }
        __syncthreads();
    }
    if (!(bid & 1)) rmsnorm_rows();
}

__device__ __forceinline__ void phase3(const Params& P, const int bid, const int gsz) {
    int tid_ = threadIdx.x; asm volatile("" : "+v"(tid_));
    unsigned char* ws = P.ws; const int gtid = bid * 512 + tid_, nthr = gsz * 512;
    bf16_t* U = (bf16_t*)(ws + O_U); const float* S = (const float*)(ws + O_SLOC);
    for (int it = gtid; it < 32 * 16 * 2 * 64; it += nthr) {
        const int p = it & 63, dir = (it >> 6) & 1, b = (it >> 7) & 15, g = it >> 11;
        float ar, ai, lr, li, tr, ti; s5_lam(P, dir, g, p, ar, ai, lr, li); cpowf_(ar, ai, 32.0f, tr, ti);
        float hr = 0.f, hi = 0.f;
        for (int c0 = 0; c0 < 64; c0 += 16) {
            float sr[16], si[16];
#pragma unroll
            for (int j = 0; j < 16; ++j) { const int c = dir ? 63 - (c0 + j) : c0 + j; const float* sp = S + ((size_t)(g * 1024 + b * 64 + c)) * 256 + dir * 128 + p; sr[j] = sp[0]; si[j] = sp[64]; }
#pragma unroll
            for (int j = 0; j < 16; ++j) { const int c = dir ? 63 - (c0 + j) : c0 + j; bf16_t* up = U + ((size_t)(g * 1024 + b * 64 + c)) * UK + 512 + dir * 128 + p;
                up[0] = f2bf(hr); up[64] = f2bf(hi);
                const float nr = tr * hr - ti * hi + sr[j], ni = tr * hi + ti * hr + si[j]; hr = nr; hi = ni; }
        }
    }
    {
        const bf16_t* EO = (const bf16_t*)(ws + O_Z); bf16_t* cat = (bf16_t*)(ws + O_CAT); const bf16_t* PT = (const bf16_t*)(ws + O_PQT);
        for (int it = gtid; it < 1024 * 64 * 8; it += nthr) {
            const int j0 = (it & 7) * 8, bh = (it >> 3) & 63, k = it >> 9, b = bh >> 2, h = bh & 3;
            const u32x4 e = *(const u32x4*)(EO + (size_t)k * 4352 + bh * 64 + j0); u32x4 o = *(const u32x4*)(EO + ((size_t)(1024 + k)) * 4352 + bh * 64 + j0);
            if (j0 == 0) o.x &= 0xffff0000u;
            float lo[8], hi[8];
            lo[0] = bflo(e.x) - bflo(o.x); hi[0] = bflo(e.x) + bflo(o.x); lo[1] = bfhi(e.x) - bfhi(o.x); hi[1] = bfhi(e.x) + bfhi(o.x);
            lo[2] = bflo(e.y) - bflo(o.y); hi[2] = bflo(e.y) + bflo(o.y); lo[3] = bfhi(e.y) - bfhi(o.y); hi[3] = bfhi(e.y) + bfhi(o.y);
            lo[4] = bflo(e.z) - bflo(o.z); hi[4] = bflo(e.z) + bflo(o.z); lo[5] = bfhi(e.z) - bfhi(o.z); hi[5] = bfhi(e.z) + bfhi(o.z);
            lo[6] = bflo(e.w) - bflo(o.w); hi[6] = bflo(e.w) + bflo(o.w); lo[7] = bfhi(e.w) - bfhi(o.w); hi[7] = bfhi(e.w) + bfhi(o.w);
            bf16_t* ra = cat + ((size_t)(b * 2048 + k)) * 1024 + 512 + h * 128; bf16_t* rb = cat + ((size_t)(b * 2048 + 2048 - k)) * 1024 + 512 + h * 128;
            u32x4 wl, wh; wl.x = cvt_pk_bf16(lo[0], lo[1]); wl.y = cvt_pk_bf16(lo[2], lo[3]); wl.z = cvt_pk_bf16(lo[4], lo[5]); wl.w = cvt_pk_bf16(lo[6], lo[7]);
            wh.x = cvt_pk_bf16(hi[0], hi[1]); wh.y = cvt_pk_bf16(hi[2], hi[3]); wh.z = cvt_pk_bf16(hi[4], hi[5]); wh.w = cvt_pk_bf16(hi[6], hi[7]);
            *(u32x4*)(ra + j0) = wl;
            if (k > 0) *(u32x4*)(rb + j0) = wh;
#pragma unroll
            for (int i = 0; i < 8; ++i) { const int j = j0 + i; if (j > 0) { ra[128 - j] = f2bf(hi[i]); if (k > 0) rb[128 - j] = f2bf(lo[i]); } }
        }
        for (int it = gtid; it < 1024 * 64; it += nthr) {
            const int bh = it & 63, k = it >> 6, b = bh >> 2, h = bh & 3; const bf16_t v = EO[(size_t)k * 4352 + 4096 + bh];
            cat[((size_t)(b * 2048 + k)) * 1024 + 512 + h * 128 + 64] = v;
            if (k > 0) cat[((size_t)(b * 2048 + 2048 - k)) * 1024 + 512 + h * 128 + 64] = v;
        }
    }
}

__device__ __forceinline__ void phase2x(const Params& P, const int bid, const int gsz) {
    int tid_ = threadIdx.x; asm volatile("" : "+v"(tid_));
    unsigned char* ws = P.ws; const int gtid = bid * 512 + tid_, nthr = gsz * 512;
    {
        bf16_t* cat = (bf16_t*)(ws + O_CAT); const bf16_t* PT = (const bf16_t*)(ws + O_PQT);
        const int wid = tid_ >> 6, lane = tid_ & 63;
        for (int n = bid * 8 + wid; n < 64 * 65; n += gsz * 8) {
            const int bh = n / 65, j = n % 65, b = bh >> 2, h = bh & 3;
            const u32x4* pp = (const u32x4*)(PT + ((size_t)(j < 64 ? bh * 64 + j : 4096 + bh)) * 2048); float s = 0.f;
#pragma unroll
            for (int i = 0; i < 4; ++i) { const u32x4 v = pp[lane + 64 * i]; s += (bflo(v.x) - bfhi(v.x)) + (bflo(v.y) - bfhi(v.y)) + (bflo(v.z) - bfhi(v.z)) + (bflo(v.w) - bfhi(v.w)); }
#pragma unroll
            for (int o = 32; o; o >>= 1) s += __shfl_xor(s, o);
            if (lane == 0) { const bf16_t v = f2bf(s * 0.02209708691207961f); bf16_t* rr = cat + ((size_t)(b * 2048 + 1024)) * 1024 + 512 + h * 128; rr[j] = v; if (j > 0 && j < 64) rr[128 - j] = v; }
        }
    }
    bf16_t* Wy = (bf16_t*)(ws + O_WY); const float* Kt = (const float*)(ws + O_KTAB);
    for (int it = gtid; it < 32 * 32 * 16 * 32; it += nthr) {
        const int s = it & 31, h = (it >> 5) & 15, t = (it >> 9) & 31, g = it >> 14;
        float o[16];
        if (s < t) { const float* k = Kt + ((size_t)((g * 2 + 0) * 32 + (t - s))) * 256 + h * 16;
#pragma unroll
            for (int j = 0; j < 16; ++j) o[j] = k[j]; }
        else if (s > t) { const float* k = Kt + ((size_t)((g * 2 + 1) * 32 + (s - t))) * 256 + h * 16;
#pragma unroll
            for (int j = 0; j < 16; ++j) o[j] = k[j]; }
        else { const float* k0 = Kt + ((size_t)((g * 2 + 0) * 32)) * 256 + h * 16; const float* k1 = Kt + ((size_t)((g * 2 + 1) * 32)) * 256 + h * 16; const float dd = P.ssm_d[g * 16 + h];
#pragma unroll
            for (int j = 0; j < 16; ++j) o[j] = k0[j] + k1[j] + (j == h ? dd : 0.f); }
        u32x4 w0, w1; w0.x = cvt_pk_bf16(o[0], o[1]); w0.y = cvt_pk_bf16(o[2], o[3]); w0.z = cvt_pk_bf16(o[4], o[5]); w0.w = cvt_pk_bf16(o[6], o[7]);
        w1.x = cvt_pk_bf16(o[8], o[9]); w1.y = cvt_pk_bf16(o[10], o[11]); w1.z = cvt_pk_bf16(o[12], o[13]); w1.w = cvt_pk_bf16(o[14], o[15]);
        u32x4* d = (u32x4*)(Wy + ((size_t)(g * 512 + t * 16 + h)) * UK + s * 16); d[0] = w0; d[1] = w1;
    }
}

__device__ __forceinline__ void phase8(const Params& P, const int bid, const int gsz) {
    int tid_ = threadIdx.x; asm volatile("" : "+v"(tid_));
    unsigned char* ws = P.ws; const int gtid = bid * 512 + tid_, nthr = gsz * 512;
    const float* EB = (const float*)(ws + O_EB); bf16_t* act = (bf16_t*)(ws + O_ACT);
    for (int it = gtid; it < 128 * NUP; it += nthr) {
        const int pm = it / NUP, rem = it % NUP, which = rem / DFF, ch = rem % DFF;
        if ((pm & 7) == 7) continue;
        const float* e0 = EB + (size_t)(pm * 4) * NUP; const float* e1 = EB + (size_t)((pm + 1) * 4) * NUP;
        const float* rp = which ? e0 + 3 * NUP : e0 + 2 * NUP; const float* rc = which ? e1 : e0 + 3 * NUP; const float* rn = which ? e1 + NUP : e1;
        float cv[2];
#pragma unroll
        for (int bj = 0; bj < 2; ++bj) { const int col = bj * DFF + ch; cv[bj] = P.conv_b[col] + P.conv_w[col] * rp[col] + P.conv_w[NUP + col] * rc[col] + P.conv_w[2 * NUP + col] * rn[col]; }
        act[(size_t)(pm * 256 + 255 + which) * DFF + ch] = f2bf(gelu_t(cv[0]) * cv[1]);
    }
}

__device__ __forceinline__ void phase10(const Params& P, const int bid, const int gsz) {
    int tid_ = threadIdx.x; asm volatile("" : "+v"(tid_));
    const int wid = tid_ >> 6, lane = tid_ & 63; const float* ss = (const float*)(P.ws + O_SS2); const bf16_t* H2 = (const bf16_t*)(P.ws + O_CAT);
    for (int row = bid * 8 + wid; row < NTOK; row += gsz * 8) {
        const u32x4* p = (const u32x4*)(H2 + (size_t)row * DM); f32x4* d = (f32x4*)(P.out + (size_t)row * DM);
        float s = (lane < 4) ? ss[(size_t)row * 4 + lane] : 0.f;
#pragma unroll
        for (int o = 32; o; o >>= 1) s += __shfl_xor(s, o);
        const float rs = rsqrtf(s * (1.0f / DM) + EPS);
#pragma unroll
        for (int i = 0; i < 2; ++i) { const u32x4 z = p[lane + 64 * i]; const f32x4 g0 = ((const f32x4*)P.g_final)[(lane + 64 * i) * 2], g1 = ((const f32x4*)P.g_final)[(lane + 64 * i) * 2 + 1];
            d[(lane + 64 * i) * 2] = (f32x4){bflo(z.x), bfhi(z.x), bflo(z.y), bfhi(z.y)} * rs * g0; d[(lane + 64 * i) * 2 + 1] = (f32x4){bflo(z.z), bfhi(z.z), bflo(z.w), bfhi(z.w)} * rs * g1; }
    }
}

struct EpiNull {
    static constexpr bool PERM = true, HAS_PRE = false;
    float* dummy;
    __device__ __forceinline__ void operator()(const Acc& acc, const Unit& u, int wr, int wc, int fr, int fq) const {
        f32x4 s = {0.f, 0.f, 0.f, 0.f};
#pragma unroll
        for (int ai = 0; ai < 2; ++ai)
#pragma unroll
            for (int bj = 0; bj < 2; ++bj)
#pragma unroll
                for (int m = 0; m < 4; ++m)
#pragma unroll
                    for (int n = 0; n < 2; ++n) s += acc[ai][bj][m][n];
        if (s[0] + s[1] + s[2] + s[3] == 12345.678f) dummy[threadIdx.x] = s[0];
    }
};

__device__ __forceinline__ void run_phase(const Params& P0, int ph, const bool dummy, unsigned char* shm) {
    Params P = P0;
#define OPAQUE_G(p) do { __attribute__((address_space(1))) char* _g = (__attribute__((address_space(1))) char*)(p); asm volatile("" : "+s"(_g)); p = (decltype(p))_g; } while (0)
    OPAQUE_G(P.x); OPAQUE_G(P.g_mix); OPAQUE_G(P.w_in); OPAQUE_G(P.lam_re); OPAQUE_G(P.lam_im); OPAQUE_G(P.log_dt); OPAQUE_G(P.b_re); OPAQUE_G(P.b_im); OPAQUE_G(P.c_re); OPAQUE_G(P.c_im); OPAQUE_G(P.ssm_d); OPAQUE_G(P.w_glu);
    OPAQUE_G(P.b_glu); OPAQUE_G(P.w_fourier); OPAQUE_G(P.w_out); OPAQUE_G(P.g_ffn); OPAQUE_G(P.w_up); OPAQUE_G(P.conv_w); OPAQUE_G(P.conv_b); OPAQUE_G(P.w_down); OPAQUE_G(P.g_final); OPAQUE_G(P.out); OPAQUE_G(P.ws);
#undef OPAQUE_G
    int bid = blockIdx.x, gsz = gridDim.x; asm volatile("" : "+s"(bid), "+s"(gsz));
    unsigned char* ws = P.ws; LAS unsigned char* lds = (LAS unsigned char*)shm;
    Order S; S.G = gsz; S.c = bid; S.nBatch = 1; S.bA = 0; S.bB = 0;
    switch (ph) {
    case 0: phase0(P, shm, bid, gsz); break;
    case 1: { S.A = (const char*)(ws + O_XN); S.B = (const char*)(ws + O_WIN); S.nM = 128; S.nN = 4; S.rot = (gsz == 256);   S.sA = (size_t)256 * 1024 * 2; S.sB = (size_t)256 * 1024 * 2;

#if defined(REPEAT_PH) && PROBE_NULL && (REPEAT_PH == 1)
        if (dummy) { EpiNull E0{(float*)(ws + O_EB)}; gemm_phase(lds, 1024, 1024, 1024, S, E0); break; }
#endif
        EpiIn E{(bf16_t*)(ws + O_U), (bf16_t*)(ws + O_PQT)}; gemm_phase(lds, 1024, 1024, 1024, S, E); } break;
    case 2: { S.A = (const char*)(ws + O_U); S.B = (const char*)(ws + O_WST); S.nM = 4; S.nN = 1; S.nBatch = 32; S.bA = (size_t)1024 * UK * 2; S.bB = (size_t)256 * 512 * 2; S.sA = (size_t)256 * UK * 2; S.sB = (size_t)256 * 512 * 2;
        EpiSloc E{(float*)(ws + O_SLOC)}; gemm_phase(lds, 512, UK, 512, S, E);
        Order S2; S2.G = gsz; S2.c = (gsz >= 136) ? (bid + 136) % gsz : bid; S2.nBatch = 2; S2.bA = (size_t)1024 * 2048 * 2; S2.bB = (size_t)4352 * 2048 * 2; S2.A = (const char*)(ws + O_AL); S2.B = (const char*)(ws + O_PQT); S2.nM = 4; S2.nN = 17; S2.sA = (size_t)256 * 2048 * 2; S2.sB = (size_t)256 * 2048 * 2;
        EpiDft E2{(bf16_t*)(ws + O_Z)}; gemm_phase(lds, 2048, 2048, 2048, S2, E2);
        { int tid_ = threadIdx.x; asm volatile("" : "+v"(tid_));
          if (gsz >= 200) { if (bid < gsz - 136) { phase2x(P, bid, gsz - 136); p0_transposes(P, shm, tid_, bid, gsz - 136, 1); p0_c2(P, shm, tid_, bid, gsz - 136); } }
          else { phase2x(P, bid, gsz); p0_transposes(P, shm, tid_, bid, gsz, 1); p0_c2(P, shm, tid_, bid, gsz); } } } break;
    case 3: phase3(P, bid, gsz); break;
    case 4: { S.A = (const char*)(ws + O_U); S.B = (const char*)(ws + O_WY); S.nM = 4; S.nN = 2; S.nBatch = 32; S.bA = (size_t)1024 * UK * 2; S.bB = (size_t)512 * UK * 2; S.sA = (size_t)256 * UK * 2; S.sB = (size_t)256 * UK * 2;
        EpiY E{(bf16_t*)(ws + O_Z)}; gemm_phase(lds, UK, UK, UK, S, E); } break;
    case 5: { S.A = (const char*)(ws + O_Z); S.B = (const char*)(ws + O_WGLU); S.nM = 128; S.nN = 2; S.sA = (size_t)256 * 512 * 2; S.sB = (size_t)256 * 512 * 2;
        EpiGlu E{(const bf16_t*)(ws + O_Z), P.b_glu, (bf16_t*)(ws + O_CAT)}; gemm_phase(lds, 512, 512, 512, S, E); } break;
    case 6: { S.A = (const char*)(ws + O_CAT); S.B = (const char*)(ws + O_WOUT); S.nM = 128; S.nN = 4; S.sA = (size_t)256 * 1024 * 2; S.sB = (size_t)256 * 1024 * 2;

#if defined(REPEAT_PH) && PROBE_NULL && (REPEAT_PH == 6)
        if (dummy) { EpiNull E0{(float*)(ws + O_EB)}; gemm_phase(lds, 1024, 1024, 1024, S, E0); break; }
#endif
        { int tid_ = threadIdx.x; asm volatile("" : "+v"(tid_));
          const bool stag = (gsz & 1) == 0;
          if (!stag) { p0_transposes(P, shm, tid_, bid, gsz, 2); p0_transposes(P, shm, tid_, bid, gsz, 3); }
          else if (bid & 1) p0_transposes(P, shm, tid_, bid >> 1, gsz >> 1, 2);
          EpiRes<false> E{P.x, (bf16_t*)(ws + O_XN), (float*)(ws + O_SS1), (LAS float*)(lds + STAGE_BYTES)}; gemm_phase(lds, 1024, 1024, 1024, S, E);
          if (stag && !(bid & 1)) p0_transposes(P, shm, tid_, bid >> 1, gsz >> 1, 3); } } break;
    case 7: { S.A = (const char*)(ws + O_XN); S.B = (const char*)(ws + O_WUP); S.nM = 128; S.nN = 22; S.sA = (size_t)256 * 1024 * 2; S.sB = (size_t)256 * 1024 * 2;
#if defined(REPEAT_PH) && PROBE_NULL && (REPEAT_PH == 7)
        if (dummy) { EpiNull E{(float*)(ws + O_EB)}; gemm_phase(lds, 1024, 1024, 1024, S, E); break; }
#endif
        EpiUp E{(const float*)(ws + O_SS1), P.conv_w, P.conv_b, (bf16_t*)(ws + O_ACT), (float*)(ws + O_EB), (LAS float*)(lds + STAGE_BYTES)}; gemm_phase(lds, 1024, 1024, 1024, S, E); } break;
    case 8: phase8(P, bid, gsz); break;
    case 9: { S.A = (const char*)(ws + O_ACT); S.B = (const char*)(ws + O_WDN); S.nM = 128; S.nN = 4; S.sA = (size_t)256 * DFF * 2; S.sB = (size_t)256 * DFF * 2;

#if defined(REPEAT_PH) && PROBE_NULL && (REPEAT_PH == 9)
        if (dummy) { EpiNull E0{(float*)(ws + O_EB)}; gemm_phase(lds, DFF, DFF, DFF, S, E0); break; }
#endif
        if (gsz == 256) { EpiFinal EF{(const bf16_t*)(ws + O_XN), P.out, P.g_final, (float*)(ws + O_SS2), (unsigned*)(ws + O_BAR + 16384), (LAS float*)(lds + STAGE_BYTES)}; gemm_phase(lds, DFF, DFF, DFF, S, EF); break; }
        EpiRes<true> E{(const void*)(ws + O_XN), (bf16_t*)(ws + O_CAT), (float*)(ws + O_SS2), (LAS float*)(lds + STAGE_BYTES)}; gemm_phase(lds, DFF, DFF, DFF, S, E); } break;
    case 10: if (gsz != 256) phase10(P, bid, gsz); break;
    }
}


#define XB_TMO      128
#define XB_XCNT(j)  (256  + 64 * (j))
#define XB_XSUB(j)  (1280 + 64 * (j))
#define XB_XGEN(j)  (2304 + 64 * (j))
#define XB_TOP      3328
#define XB_TOPGEN   3392
#define XCD_BAR_WORDS 3456
#define XB_SPIN_CAP (1u << 22)
__device__ __forceinline__ unsigned xb_ld(unsigned* p)              { return __hip_atomic_load(p, __ATOMIC_RELAXED, __HIP_MEMORY_SCOPE_AGENT); }
__device__ __forceinline__ unsigned xb_add(unsigned* p, unsigned v) { return __hip_atomic_fetch_add(p, v, __ATOMIC_RELAXED, __HIP_MEMORY_SCOPE_AGENT); }
__device__ __forceinline__ unsigned xb_xcc_id() { return (unsigned)__builtin_amdgcn_s_getreg((3 << 11) | 20) & 0xFu; }
#define XB_SPIN(cond, bar) do { unsigned _sp = 0; while (cond) { __builtin_amdgcn_s_sleep(1); \
    if ((++_sp & 255u) == 0u) { if (xb_ld(&(bar)[XB_TMO])) break; if (_sp > XB_SPIN_CAP) { atomicAdd(&(bar)[XB_TMO], 1u); break; } } } } while (0)
struct XcdBarrier { unsigned* bar; unsigned x; volatile LAS unsigned* st; };
__device__ __forceinline__ XcdBarrier xcd_barrier_post(unsigned* bar, volatile LAS unsigned* st) {
    XcdBarrier b; b.bar = bar; b.x = xb_xcc_id(); b.st = st;
    if (threadIdx.x == 0) (void)xb_add(&bar[XB_XCNT(b.x)], 1u);
    return b;
}
__device__ __forceinline__ void xcd_barrier_complete(unsigned* bar, unsigned x, unsigned& nloc, unsigned& nx) {
    const unsigned G = gridDim.x * gridDim.y * gridDim.z;
    unsigned sum, cnt, mine, sp = 0u;
    for (;;) {
        sum = 0u; cnt = 0u; mine = 0u;
#pragma unroll
        for (unsigned j = 0; j < 16; ++j) { const unsigned c = xb_ld(&bar[XB_XCNT(j)]); sum += c; cnt += (c > 0u) ? 1u : 0u; mine = (j == x) ? c : mine; }
        if (sum == G) break;
        __builtin_amdgcn_s_sleep(1);
        if ((++sp & 255u) == 0u) { if (xb_ld(&bar[XB_TMO])) break; if (sp > XB_SPIN_CAP) { atomicAdd(&bar[XB_TMO], 1u); break; } }
    }
    nloc = mine > 0u ? mine : 1u; nx = cnt > 0u ? cnt : 1u;
}
__device__ __forceinline__ void xcd_barrier(const XcdBarrier& b) {
    asm volatile("s_waitcnt vmcnt(0)" ::: "memory");
    __syncthreads();
    if (threadIdx.x == 0) {
        unsigned* bar = b.bar;
        __builtin_amdgcn_s_waitcnt(0);
        unsigned nloc = b.st[0], nx = b.st[1];
        if (nloc == 0u) { xcd_barrier_complete(bar, b.x, nloc, nx); b.st[0] = nloc; b.st[1] = nx; }
        const unsigned old = xb_add(&bar[XB_XSUB(b.x)], 1u);
        const unsigned gen = old / nloc;
        if (old + 1u == (gen + 1u) * nloc) {
            __builtin_amdgcn_fence(__ATOMIC_RELEASE, "agent");
            asm volatile("s_waitcnt vmcnt(0)" ::: "memory");
            const unsigned og = xb_add(&bar[XB_TOP], 1u);
            const unsigned tg = og / nx;
            if (og + 1u == (tg + 1u) * nx) xb_add(&bar[XB_TOPGEN], 1u);
            else XB_SPIN(xb_ld(&bar[XB_TOPGEN]) == tg, bar);
            __builtin_amdgcn_fence(__ATOMIC_ACQUIRE, "agent");
            xb_add(&bar[XB_XGEN(b.x)], 1u);
            asm volatile("s_waitcnt vmcnt(0)" ::: "memory");
        } else {
            XB_SPIN(xb_ld(&bar[XB_XGEN(b.x)]) == gen, bar);
            __builtin_amdgcn_fence(__ATOMIC_ACQUIRE, "agent");
            asm volatile("s_waitcnt vmcnt(0)" ::: "memory");
        }
    }
    __syncthreads();
}

__global__ __launch_bounds__(512, 2) void k_mega(Params P) {
    extern __shared__ __attribute__((aligned(16))) unsigned char shm[];
    volatile LAS unsigned* xst = (volatile LAS unsigned*)((LAS unsigned char*)shm + LDS_BYTES - 16);
    if (threadIdx.x == 0) { xst[0] = 0u; xst[1] = 0u; }
    __syncthreads();
    const XcdBarrier xb = xcd_barrier_post((unsigned*)(P.ws + O_BAR), xst);
#define SEAM(k) xcd_barrier(xb)
    #ifdef REPEAT_PH
    _Pragma("nounroll") for (int i = 0; i < NPH + 1; ++i) { int phv = __builtin_amdgcn_readfirstlane((i <= REPEAT_PH) ? i : i - 1); asm volatile("" : "+s"(phv)); run_phase(P, phv, i == REPEAT_PH, shm); if (i < NPH) SEAM(i); }
#else
    _Pragma("nounroll") for (int ph = 0; ph < NPH; ++ph) { int phv = ph; asm volatile("" : "+s"(phv)); run_phase(P, phv, false, shm); if (ph + 1 < NPH && !(ph == 9 && gridDim.x == 256)) SEAM(ph); }
#endif
}
__global__ __launch_bounds__(512, 2) void k_phase(Params P, int ph) {
    extern __shared__ __attribute__((aligned(16))) unsigned char shm[];
    run_phase(P, ph, false, shm);
}

extern "C" void kernel_launch(void* const* d_in, const int* in_sizes, int n_in, void* d_out, int out_size, void* d_ws, size_t ws_size, hipStream_t stream) {
    static int grid = 0;
    if (grid == 0) {
        if (n_in != 21 || ws_size < WS_NEED || out_size != NTOK * DM) { fprintf(stderr, "kernel_launch: unexpected shapes (n_in %d, ws %zu need %zu, out %d)\n", n_in, ws_size, (size_t)WS_NEED, out_size); grid = -1; return; }
        int dev = 0, cus = 0, per_cu = 0;
        hipGetDevice(&dev); hipDeviceGetAttribute(&cus, hipDeviceAttributeMultiprocessorCount, dev);
        hipFuncSetAttribute((const void*)k_mega, hipFuncAttributeMaxDynamicSharedMemorySize, LDS_BYTES);
        hipFuncSetAttribute((const void*)k_phase, hipFuncAttributeMaxDynamicSharedMemorySize, LDS_BYTES);
        hipOccupancyMaxActiveBlocksPerMultiprocessor(&per_cu, (const void*)k_mega, 512, LDS_BYTES);
        if (per_cu < 1) { fprintf(stderr, "kernel_launch: occupancy query says %d blocks per CU\n", per_cu); per_cu = 1; }
        grid = cus * per_cu; if (grid > 256) grid = 256;
        (void)hipGetLastError();
    }
    if (grid < 0) return;
    Params P{};
    const float** pp = (const float**)&P;
    for (int i = 0; i < 21; ++i) pp[i] = (const float*)d_in[i];
    P.out = (float*)d_out; P.ws = (unsigned char*)d_ws;
#if ONE_LAUNCH
    if (hipMemsetAsync((unsigned char*)d_ws + O_BAR, 0, BAR_BYTES, stream) != hipSuccess) { fprintf(stderr, "kernel_launch: memset of the barrier words failed\n"); return; }
    void* args[] = {&P};
    hipError_t e = hipLaunchCooperativeKernel((const void*)k_mega, dim3(grid), dim3(512), args, LDS_BYTES, stream);
    if (e != hipSuccess) fprintf(stderr, "cooperative launch failed: %s (grid %d)\n", hipGetErrorString(e), grid);
#else
    for (int ph = 0; ph < NPH; ++ph) hipLaunchKernelGGL(k_phase, dim3(grid), dim3(512), LDS_BYTES, stream, P, ph);
#endif
}
```

```cpp
#include <hip/hip_runtime.h>
#include <hip/hip_cooperative_groups.h>
#include <cstdio>
namespace cg = cooperative_groups;

#ifndef ONE_LAUNCH
#define ONE_LAUNCH 1
#endif
#ifndef SLOW_GEMM
#define SLOW_GEMM 0
#endif
#ifndef GEMM_SP2
#define GEMM_SP2 1
#endif

#define LAS __attribute__((address_space(3)))
typedef unsigned short bf16_t;
typedef short bf16x8 __attribute__((ext_vector_type(8)));
typedef float f32x4 __attribute__((ext_vector_type(4)));
typedef unsigned u32x4 __attribute__((ext_vector_type(4)));
typedef unsigned u32x2 __attribute__((ext_vector_type(2)));

constexpr int NTOK = 32768, DM = 1024, NUP = 5632, DFF = 2816, UK = 768;
constexpr float EPS = 1e-6f;
constexpr int BM = 256, BK = 64, HALF = 128, HTB = HALF * BK * 2, STAGE_BYTES = 8 * HTB;
constexpr int LDS_BYTES = STAGE_BYTES + 18432;
constexpr int NPH = 11;

constexpr size_t O_WIN = 0;
constexpr size_t O_WGLU = O_WIN + (size_t)1536 * 1024 * 2;
constexpr size_t O_WOUT = O_WGLU + (size_t)512 * 512 * 2;
constexpr size_t O_WUP = O_WOUT + (size_t)1024 * 1024 * 2;
constexpr size_t O_WDN = O_WUP + (size_t)5632 * 1024 * 2;
constexpr size_t O_AL = O_WDN + (size_t)1024 * 2816 * 2;
constexpr size_t O_WST = O_AL + (size_t)2048 * 4096 * 2;
constexpr size_t O_WY = O_WST + (size_t)32 * 256 * 512 * 2;
constexpr size_t O_KTAB = O_WY + (size_t)32 * 512 * 768 * 2;
constexpr size_t O_SS1 = O_KTAB + (size_t)32 * 2 * 32 * 256 * 4;
constexpr size_t O_SS2 = O_SS1 + (size_t)32768 * 16 * 4;
constexpr size_t O_EB = O_SS2 + (size_t)32768 * 16 * 4;
constexpr size_t O_XN = O_EB + (size_t)128 * 4 * 5632 * 4;
constexpr size_t O_CAT = O_XN + (size_t)32768 * 1024 * 2;
constexpr size_t O_U = O_CAT + (size_t)32768 * 1024 * 2;
constexpr size_t O_PQT = O_U + (size_t)32 * 1024 * 768 * 2;
constexpr size_t O_SLOC = O_PQT + (size_t)8192 * 4096 * 2;
constexpr size_t O_Z = O_SLOC + (size_t)32 * 1024 * 256 * 4;
constexpr size_t O_ACT = O_U;
constexpr size_t O_BAR = O_Z + (size_t)32768 * 512 * 2;
constexpr size_t BAR_BYTES = 65536;
constexpr size_t WS_NEED = O_BAR + BAR_BYTES;

struct Params {
    const float *x, *g_mix, *w_in, *lam_re, *lam_im, *log_dt, *b_re, *b_im, *c_re, *c_im, *ssm_d, *w_glu, *b_glu, *w_fourier, *w_out, *g_ffn, *w_up, *conv_w, *conv_b, *w_down, *g_final;
    float* out; unsigned char* ws;
};

__device__ __forceinline__ unsigned cvt_pk_bf16(float lo, float hi) { unsigned r; asm volatile("v_cvt_pk_bf16_f32 %0, %1, %2" : "=v"(r) : "v"(lo), "v"(hi)); return r; }
__device__ __forceinline__ bf16_t f2bf(float f) { return (bf16_t)(cvt_pk_bf16(f, 0.f) & 0xffffu); }
__device__ __forceinline__ float bflo(unsigned w) { return __uint_as_float(w << 16); }
__device__ __forceinline__ float bfhi(unsigned w) { return __uint_as_float(w & 0xffff0000u); }
__device__ __forceinline__ float gelu_t(float x) {
    const float u = x * (1.0f + 0.044715f * x * x);
    const float e = __builtin_amdgcn_exp2f(-2.0f * 0.7978845608f * 1.4426950409f * u);
    return x * __builtin_amdgcn_rcpf(1.0f + e);
}
typedef float f32x2 __attribute__((ext_vector_type(2)));
template <int CTRL> __device__ __forceinline__ float dpp_rot(float src) { return __int_as_float(__builtin_amdgcn_mov_dpp(__float_as_int(src), CTRL, 0xf, 0xf, false)); }
__device__ __forceinline__ f32x2 gelu_t2(f32x2 x) {
    const f32x2 u = x * (x * x * 0.044715f + 1.0f), a = u * (-2.0f * 0.7978845608f * 1.4426950409f);
    f32x2 e; e[0] = __builtin_amdgcn_exp2f(a[0]); e[1] = __builtin_amdgcn_exp2f(a[1]);
    const f32x2 d = e + 1.0f; f32x2 r; r[0] = __builtin_amdgcn_rcpf(d[0]); r[1] = __builtin_amdgcn_rcpf(d[1]);
    return x * r;
}
template <int CTRL> __device__ __forceinline__ float dpp_mov(float src) { return __int_as_float(__builtin_amdgcn_update_dpp(0, __float_as_int(src), CTRL, 0xf, 0xf, false)); }
template <int CTRL> __device__ __forceinline__ float dpp_upd(float old, float src) { return __int_as_float(__builtin_amdgcn_update_dpp(__float_as_int(old), __float_as_int(src), CTRL, 0xf, 0xf, false)); }
__device__ __forceinline__ float sigmoid_f(float g) { return __builtin_amdgcn_rcpf(1.0f + __builtin_amdgcn_exp2f(-1.4426950409f * g)); }

__device__ __forceinline__ int lds_byte(int r, int c) { const int st = (r >> 4) * 2 + (c >> 5), rr = r & 15, cc = c & 31, ob = rr * 64 + cc * 2; return st * 1024 + (ob ^ (((ob >> 9) & 1) << 5)); }
__device__ __forceinline__ void stage_rc(int b, int& R, int& C) { const int st = b / 1024, sb = b % 1024, swz = sb ^ (((sb >> 9) & 1) << 5); R = (st >> 1) * 16 + swz / 64; C = (st & 1) * 32 + (swz % 64) / 2; }
__device__ __forceinline__ int perm32(int rho) { const int n = rho >> 4, i = rho & 15; return 8 * (i >> 2) + 4 * n + (i & 3); }

struct Unit { const char* A; const char* B; int pm, pn, aux; };
struct Order {
    const char* A; const char* B; int nM, nN, nBatch; size_t bA, bB, sA, sB; int G, c;
    __device__ __forceinline__ bool next(int i, Unit& u) const {
        const int per = nM * nN; long L = (long)i * G + c;
        if (nBatch > 1 && per <= G / 8 && (G / 8) % per == 0) {
            const int xcd = c & 7, slot = c >> 3, bpx = (G / 8) / per, b = i * 8 * bpx + (slot / per) * 8 + xcd;
            if (b >= nBatch) return false;
            L = (long)b * per + slot % per;
        }
        if (L >= (long)per * nBatch) return false;
        const int bt = (int)(L / per); int w = (int)(L % per); int pm, pn;
        if (nBatch == 1) {
            const int nwg = per; int wgid = w; { const int q = nwg / 8, r = nwg % 8, xcd = wgid % 8, off = wgid / 8; wgid = (xcd < r ? xcd * (q + 1) : r * (q + 1) + (xcd - r) * q) + off; }
            const int nig = 8 * nN, gid = wgid / nig, fm = gid * 8, gsz = (nM - fm) < 8 ? (nM - fm) : 8;
            pm = fm + ((wgid % nig) % gsz); pn = (wgid % nig) / gsz;
        } else { pm = w / nN; pn = w % nN; }
        u.pm = pm; u.pn = pn; u.aux = bt; u.A = A + (size_t)bt * bA + (size_t)pm * sA; u.B = B + (size_t)bt * bB + (size_t)pn * sB; return true;
    }
};

template <class Epi>
__device__ __forceinline__ void gemm_phase(LAS unsigned char* lds, const int K, const int lda, const int ldb, const Order& S, const Epi& E) {
    int tid_ = threadIdx.x; asm volatile("" : "+v"(tid_));
    const int tid = tid_, wid = __builtin_amdgcn_readfirstlane(tid >> 6), lane = tid & 63, wr = wid >> 2, wc = wid & 3, fr = lane & 15, fq = lane >> 4;
    Unit cur, nxt; int ui = 0;
    if (!S.next(0, cur)) return;
    f32x4 acc[2][2][4][2];
#if SLOW_GEMM
    for (;;) {
#pragma unroll
        for (int ai = 0; ai < 2; ++ai)
#pragma unroll
            for (int bj = 0; bj < 2; ++bj)
#pragma unroll
                for (int m = 0; m < 4; ++m)
#pragma unroll
                    for (int n = 0; n < 2; ++n)
#pragma unroll
                        for (int e = 0; e < 4; ++e) {
                            const int row = 128 * ai + 64 * wr + 16 * m + fr, col = Epi::PERM ? (128 * bj + 32 * wc + 8 * fq + 4 * n + e) : (128 * bj + 32 * wc + 16 * n + 4 * fq + e);
                            const u32x4* ap = (const u32x4*)(cur.A + (size_t)row * lda * 2); const u32x4* bp = (const u32x4*)(cur.B + (size_t)col * ldb * 2);
                            float s = 0.f;
                            for (int k = 0; k < K / 8; ++k) { const u32x4 a = ap[k], b = bp[k];
                                s += bflo(a.x) * bflo(b.x) + bfhi(a.x) * bfhi(b.x) + bflo(a.y) * bflo(b.y) + bfhi(a.y) * bfhi(b.y) + bflo(a.z) * bflo(b.z) + bfhi(a.z) * bfhi(b.z) + bflo(a.w) * bflo(b.w) + bfhi(a.w) * bfhi(b.w); }
                            acc[ai][bj][m][n][e] = s;
                        }
        E(acc, cur, wr, wc, fr, fq);
        if (!S.next(++ui, nxt)) break;
        cur = nxt;
    }
    if (wr == 0) __builtin_amdgcn_s_barrier();
    __builtin_amdgcn_s_barrier();
#else
    int nt = K / BK; asm volatile("" : "+s"(nt));
    unsigned voffA[2], voffB[2];
#pragma unroll
    for (int i = 0; i < 2; ++i) { int R, C; stage_rc(tid * 16 + i * 8192, R, C); const int Rb = Epi::PERM ? ((R & ~31) + perm32(R & 31)) : R;
        voffA[i] = (unsigned)(R * lda + C) * 2u; voffB[i] = (unsigned)(Rb * ldb + C) * 2u; }
    const size_t kstep = (size_t)(BK * 2);
    const size_t hA = (size_t)HALF * lda * 2, hB = (size_t)HALF * ldb * 2;
    const unsigned ldsw = (unsigned)wid * 1024u;
    const int aoff = lds_byte(wr * 64 + fr, fq * 8), boff = lds_byte(wc * 32 + fr, fq * 8);
#define PG8_SA(b, h) (((b) * 2 + (h)) * HTB)
#define PG8_SB(b, h) ((4 + (b) * 2 + (h)) * HTB)
#define PG8_STAGE(bufoff, gbase, voff) do { _Pragma("unroll") for (int _i = 0; _i < 2; ++_i) \
        __builtin_amdgcn_global_load_lds((const unsigned*)((const char*)(gbase) + (voff)[_i]), (LAS unsigned*)(lds + (bufoff) + ldsw + _i * 8192), 16, 0, 0); } while (0)
#define PG8_LDA(dst, b, h) do { _Pragma("unroll") for (int m = 0; m < 4; ++m) _Pragma("unroll") for (int k = 0; k < 2; ++k) dst[m][k] = *(const LAS bf16x8*)(lds + PG8_SA(b, h) + aoff + m * 2048 + k * 1024); } while (0)
#define PG8_LDB(dst, b, h) do { _Pragma("unroll") for (int n = 0; n < 2; ++n) _Pragma("unroll") for (int k = 0; k < 2; ++k) dst[n][k] = *(const LAS bf16x8*)(lds + PG8_SB(b, h) + boff + n * 2048 + k * 1024); } while (0)
#define PG8_MMA(ai, bj, At, Bt) do { __builtin_amdgcn_s_setprio(1); _Pragma("unroll") for (int m = 0; m < 4; ++m) _Pragma("unroll") for (int n = 0; n < 2; ++n) _Pragma("unroll") for (int k = 0; k < 2; ++k) \
        acc[ai][bj][m][n] = __builtin_amdgcn_mfma_f32_16x16x32_bf16(Bt[n][k], At[m][k], acc[ai][bj][m][n], 0, 0, 0); __builtin_amdgcn_s_setprio(0); } while (0)
#define PG8_WAIT_V(n) asm volatile("s_waitcnt vmcnt(" #n ")" ::: "memory")
#define PG8_WAIT_L(n) asm volatile("s_waitcnt lgkmcnt(" #n ")" ::: "memory")
#define PG8_BAR __builtin_amdgcn_s_barrier()
#define PG8_SCHED __builtin_amdgcn_sched_barrier(0)
#pragma unroll
    for (int a = 0; a < 2; ++a)
#pragma unroll
        for (int b = 0; b < 2; ++b)
#pragma unroll
            for (int m = 0; m < 4; ++m)
#pragma unroll
                for (int n = 0; n < 2; ++n) acc[a][b][m][n] = (f32x4){0.f, 0.f, 0.f, 0.f};
    bf16x8 At[4][2], B0[2][2], B1[2][2];
    const char* cA = cur.A; const char* cB = cur.B;
#if GEMM_SP2
    PG8_STAGE(PG8_SB(0, 0), cB, voffB); PG8_STAGE(PG8_SB(0, 1), cB + hB, voffB); PG8_STAGE(PG8_SA(0, 0), cA, voffA); PG8_STAGE(PG8_SA(0, 1), cA + hA, voffA);
    if (wr == 1) PG8_BAR;
    PG8_WAIT_V(2); PG8_BAR;
    PG8_STAGE(PG8_SB(1, 0), cB + kstep, voffB); PG8_STAGE(PG8_SA(1, 0), cA + kstep, voffA); PG8_STAGE(PG8_SB(1, 1), cB + hB + kstep, voffB);
    PG8_WAIT_V(6); PG8_BAR;
#else
    PG8_STAGE(PG8_SB(0, 0), cB, voffB); PG8_STAGE(PG8_SA(0, 0), cA, voffA); PG8_STAGE(PG8_SB(0, 1), cB + hB, voffB); PG8_STAGE(PG8_SA(0, 1), cA + hA, voffA);
    if (wr == 1) PG8_BAR;
    PG8_WAIT_V(4); PG8_BAR;
    PG8_STAGE(PG8_SB(1, 0), cB + kstep, voffB); PG8_STAGE(PG8_SA(1, 0), cA + kstep, voffA); PG8_STAGE(PG8_SB(1, 1), cB + hB + kstep, voffB);
    PG8_WAIT_V(6); PG8_BAR;
#endif
    for (;;) {
        const bool has_next = S.next(ui + 1, nxt);
        const char* nA = has_next ? nxt.A : cA; const char* nB = has_next ? nxt.B : cB;
        _Pragma("nounroll") for (int t = 0; t < nt; t += 2) {
            const bool last = (t == nt - 2);
            const char* a1 = cA + (size_t)(t + 1) * kstep;
            const char* a2 = last ? nA : cA + (size_t)(t + 2) * kstep; const char* b2 = last ? nB : cB + (size_t)(t + 2) * kstep;
            const char* a3 = a2 + kstep; const char* b3 = b2 + kstep;
#if GEMM_SP2
            PG8_LDB(B0, 0, 0); PG8_LDB(B1, 0, 1); PG8_SCHED; PG8_LDA(At, 0, 0); PG8_STAGE(PG8_SA(1, 1), a1 + hA, voffA);
            if (t != 0) PG8_WAIT_V(8);
            PG8_WAIT_L(0); PG8_BAR;
            if constexpr (Epi::HAS_PRE) { if (t == 0) E.pre(cur, wid, lane); }
            PG8_MMA(0, 0, At, B0); PG8_MMA(0, 1, At, B1); PG8_BAR; PG8_SCHED;
            PG8_LDA(At, 0, 1); PG8_STAGE(PG8_SB(0, 0), b2, voffB); PG8_STAGE(PG8_SB(0, 1), b2 + hB, voffB); PG8_STAGE(PG8_SA(0, 0), a2, voffA);
            PG8_WAIT_V(8); PG8_WAIT_L(0); PG8_BAR; PG8_MMA(1, 0, At, B0); PG8_MMA(1, 1, At, B1); PG8_BAR; PG8_SCHED;
            PG8_LDB(B0, 1, 0); PG8_LDB(B1, 1, 1); PG8_SCHED; PG8_LDA(At, 1, 0); PG8_STAGE(PG8_SA(0, 1), a2 + hA, voffA);
            PG8_WAIT_V(8); PG8_WAIT_L(0); PG8_BAR; PG8_MMA(0, 0, At, B0); PG8_MMA(0, 1, At, B1); PG8_BAR; PG8_SCHED;
            PG8_LDA(At, 1, 1); PG8_STAGE(PG8_SB(1, 0), b3, voffB); PG8_STAGE(PG8_SB(1, 1), b3 + hB, voffB); PG8_STAGE(PG8_SA(1, 0), a3, voffA);
            if (last) PG8_WAIT_V(6); else PG8_WAIT_V(8);
            PG8_WAIT_L(0); PG8_BAR; PG8_MMA(1, 0, At, B0); PG8_MMA(1, 1, At, B1); PG8_BAR; PG8_SCHED;
#else
            PG8_LDB(B0, 0, 0); PG8_SCHED; PG8_LDA(At, 0, 0); PG8_STAGE(PG8_SA(1, 1), a1 + hA, voffA);
            PG8_WAIT_L(8); PG8_BAR;
            if constexpr (Epi::HAS_PRE) { if (t == 0) E.pre(cur, wid, lane); }
            PG8_WAIT_L(0); PG8_MMA(0, 0, At, B0); PG8_BAR; PG8_SCHED;
            PG8_LDB(B1, 0, 1); PG8_STAGE(PG8_SB(0, 0), b2, voffB);
            PG8_BAR; PG8_WAIT_L(0); PG8_MMA(0, 1, At, B1); PG8_BAR;
            PG8_LDA(At, 0, 1); PG8_STAGE(PG8_SA(0, 0), a2, voffA);
            PG8_BAR; PG8_WAIT_L(0); PG8_MMA(1, 0, At, B0); PG8_BAR; PG8_SCHED;
            PG8_STAGE(PG8_SB(0, 1), b2 + hB, voffB);
            PG8_WAIT_V(6); PG8_BAR; PG8_MMA(1, 1, At, B1); PG8_BAR;
            PG8_LDB(B0, 1, 0); PG8_SCHED; PG8_LDA(At, 1, 0); PG8_STAGE(PG8_SA(0, 1), a2 + hA, voffA);
            PG8_WAIT_L(8); PG8_BAR; PG8_WAIT_L(0); PG8_MMA(0, 0, At, B0); PG8_BAR; PG8_SCHED;
            PG8_LDB(B1, 1, 1); PG8_STAGE(PG8_SB(1, 0), b3, voffB);
            PG8_BAR; PG8_WAIT_L(0); PG8_MMA(0, 1, At, B1); PG8_BAR;
            PG8_LDA(At, 1, 1); PG8_STAGE(PG8_SA(1, 0), a3, voffA);
            PG8_BAR; PG8_WAIT_L(0); PG8_MMA(1, 0, At, B0); PG8_BAR; PG8_SCHED;
            PG8_STAGE(PG8_SB(1, 1), b3 + hB, voffB);
            PG8_WAIT_V(6); PG8_BAR; PG8_MMA(1, 1, At, B1); PG8_BAR;
#endif
        }
        if (wr == 0) PG8_BAR;
        E(acc, cur, wr, wc, fr, fq);
        if (wr == 1) PG8_BAR;
        if (!has_next) break;
#pragma unroll
        for (int a = 0; a < 2; ++a)
#pragma unroll
            for (int b = 0; b < 2; ++b)
#pragma unroll
                for (int m = 0; m < 4; ++m)
#pragma unroll
                    for (int n = 0; n < 2; ++n) acc[a][b][m][n] = (f32x4){0.f, 0.f, 0.f, 0.f};
        cur = nxt; cA = nA; cB = nB; ++ui;
    }
    PG8_WAIT_V(0);
    if (wr == 0) PG8_BAR;
    PG8_BAR;
#undef PG8_SA
#undef PG8_SB
#undef PG8_STAGE
#undef PG8_LDA
#undef PG8_LDB
#undef PG8_MMA
#undef PG8_WAIT_V
#undef PG8_WAIT_L
#undef PG8_BAR
#undef PG8_SCHED
#endif
}

typedef f32x4 Acc[2][2][4][2];
__device__ __forceinline__ u32x4 pack8(const f32x4 a, const f32x4 b) { u32x4 w; w.x = cvt_pk_bf16(a[0], a[1]); w.y = cvt_pk_bf16(a[2], a[3]); w.z = cvt_pk_bf16(b[0], b[1]); w.w = cvt_pk_bf16(b[2], b[3]); return w; }

struct EpiIn {
    static constexpr bool PERM = true, HAS_PRE = false;
    bf16_t* U; bf16_t* PQT;
    __device__ __forceinline__ void operator()(const Acc& acc, const Unit& u, int wr, int wc, int fr, int fq) const {
#pragma unroll
        for (int ai = 0; ai < 2; ++ai)
#pragma unroll
            for (int m = 0; m < 4; ++m) {
                const int tok = u.pm * 256 + 128 * ai + 64 * wr + 16 * m + fr;
#pragma unroll
                for (int bj = 0; bj < 2; ++bj) {
                    if (u.pn < 2) {
                        const int c = 256 * u.pn + 128 * bj + 32 * wc + 8 * fq, g = c >> 4, h0 = c & 15;
                        *(u32x4*)(U + ((size_t)(g * 1024 + (tok >> 5))) * UK + (tok & 31) * 16 + h0) = pack8(acc[ai][bj][m][0], acc[ai][bj][m][1]);
                    } else {
                        const int b = tok >> 11, l = tok & 2047;
#pragma unroll
                        for (int n = 0; n < 2; ++n)
#pragma unroll
                            for (int e = 0; e < 4; ++e) {
                                const int cc = 256 * (u.pn - 2) + 128 * bj + 32 * wc + 8 * fq + 4 * n + e, h = cc >> 7, r = cc & 127, bh = b * 4 + h;
                                const size_t row = (r < 64) ? (size_t)(bh * 64 + r) : (r == 64) ? (size_t)(4096 + bh) : (size_t)(4352 + bh * 64 + (r - 64));
                                PQT[row * 2048 + l] = f2bf(acc[ai][bj][m][n][e]);
                            }
                    }
                }
            }
    }
};
struct EpiSloc {
    static constexpr bool PERM = false, HAS_PRE = false;
    float* S;
    __device__ __forceinline__ void operator()(const Acc& acc, const Unit& u, int wr, int wc, int fr, int fq) const {
#pragma unroll
        for (int ai = 0; ai < 2; ++ai)
#pragma unroll
            for (int m = 0; m < 4; ++m) {
                float* rp = S + ((size_t)(u.aux * 1024 + u.pm * 256 + 128 * ai + 64 * wr + 16 * m + fr)) * 256 + 32 * wc + 4 * fq;
#pragma unroll
                for (int bj = 0; bj < 2; ++bj)
#pragma unroll
                    for (int n = 0; n < 2; ++n) *(f32x4*)(rp + 128 * bj + 16 * n) = acc[ai][bj][m][n];
            }
    }
};
struct EpiDft {
    static constexpr bool PERM = true, HAS_PRE = false;
    bf16_t* EO;
    __device__ __forceinline__ void operator()(const Acc& acc, const Unit& u, int wr, int wc, int fr, int fq) const {
#pragma unroll
        for (int ai = 0; ai < 2; ++ai)
#pragma unroll
            for (int m = 0; m < 4; ++m) {
                const int k = u.pm * 256 + 128 * ai + 64 * wr + 16 * m + fr;
#pragma unroll
                for (int bj = 0; bj < 2; ++bj) {
                    const int n = 256 * u.pn + 128 * bj + 32 * wc + 8 * fq;
                    *(u32x4*)(EO + ((size_t)(u.aux * 1024 + k)) * 4352 + n) = pack8(acc[ai][bj][m][0], acc[ai][bj][m][1]);
                }
            }
    }
};
struct EpiY {
    static constexpr bool PERM = true, HAS_PRE = false;
    bf16_t* Z;
    __device__ __forceinline__ void operator()(const Acc& acc, const Unit& u, int wr, int wc, int fr, int fq) const {
#pragma unroll
        for (int ai = 0; ai < 2; ++ai)
#pragma unroll
            for (int m = 0; m < 4; ++m) {
                const int R = u.pm * 256 + 128 * ai + 64 * wr + 16 * m + fr;
#pragma unroll
                for (int bj = 0; bj < 2; ++bj) {
                    const int c = 256 * u.pn + 128 * bj + 32 * wc + 8 * fq, t = c >> 4, h0 = c & 15;
                    f32x4 a = acc[ai][bj][m][0], b = acc[ai][bj][m][1];
                    { const f32x2 g0 = gelu_t2((f32x2){a[0], a[1]}), g1 = gelu_t2((f32x2){a[2], a[3]}), g2 = gelu_t2((f32x2){b[0], b[1]}), g3 = gelu_t2((f32x2){b[2], b[3]});
                      a = (f32x4){g0[0], g0[1], g1[0], g1[1]}; b = (f32x4){g2[0], g2[1], g3[0], g3[1]}; }
                    *(u32x4*)(Z + ((size_t)(R * 32 + t)) * 512 + u.aux * 16 + h0) = pack8(a, b);
                }
            }
    }
};
struct EpiGlu {
    static constexpr bool PERM = true, HAS_PRE = false;
    const bf16_t* Z; const float* bias; bf16_t* cat;
    __device__ __forceinline__ void operator()(const Acc& acc, const Unit& u, int wr, int wc, int fr, int fq) const {
        const int c0 = 256 * u.pn + 32 * wc + 8 * fq, tok0 = u.pm * 256 + 64 * wr + fr;
        f32x4 bv[2][2];
#pragma unroll
        for (int bj = 0; bj < 2; ++bj) { bv[bj][0] = *(const f32x4*)(bias + c0 + 128 * bj); bv[bj][1] = *(const f32x4*)(bias + c0 + 128 * bj + 4); }
#pragma unroll
        for (int ai = 0; ai < 2; ++ai) {
            u32x4 zz[4][2];
#pragma unroll
            for (int m = 0; m < 4; ++m)
#pragma unroll
                for (int bj = 0; bj < 2; ++bj) zz[m][bj] = *(const u32x4*)(Z + (size_t)(tok0 + 128 * ai + 16 * m) * 512 + c0 + 128 * bj);
#pragma unroll
            for (int m = 0; m < 4; ++m)
#pragma unroll
                for (int bj = 0; bj < 2; ++bj) {
                    const u32x4 z = zz[m][bj];
                    f32x4 a = acc[ai][bj][m][0] + bv[bj][0], b = acc[ai][bj][m][1] + bv[bj][1];
                    a[0] = bflo(z.x) * sigmoid_f(a[0]); a[1] = bfhi(z.x) * sigmoid_f(a[1]); a[2] = bflo(z.y) * sigmoid_f(a[2]); a[3] = bfhi(z.y) * sigmoid_f(a[3]);
                    b[0] = bflo(z.z) * sigmoid_f(b[0]); b[1] = bfhi(z.z) * sigmoid_f(b[1]); b[2] = bflo(z.w) * sigmoid_f(b[2]); b[3] = bfhi(z.w) * sigmoid_f(b[3]);
                    *(u32x4*)(cat + (size_t)(tok0 + 128 * ai + 16 * m) * 1024 + c0 + 128 * bj) = pack8(a, b);
                }
        }
    }
};
template <bool BASE_BF> struct EpiRes {
    static constexpr bool PERM = true, HAS_PRE = false;
    const void* base; bf16_t* H; float* ss; LAS float* RED;
    __device__ __forceinline__ void operator()(const Acc& acc, const Unit& u, int wr, int wc, int fr, int fq) const {
        const int c0 = 256 * u.pn + 32 * wc + 8 * fq, tok0 = u.pm * 256 + 64 * wr + fr;
        float sarr[8];
#pragma unroll
        for (int ai = 0; ai < 2; ++ai) {
            f32x4 bv[4][2][2]; u32x4 bz[4][2];
#pragma unroll
            for (int m = 0; m < 4; ++m)
#pragma unroll
                for (int bj = 0; bj < 2; ++bj) { const size_t o = (size_t)(tok0 + 128 * ai + 16 * m) * 1024 + c0 + 128 * bj;
                    if (BASE_BF) bz[m][bj] = *(const u32x4*)((const bf16_t*)base + o);
                    else { bv[m][bj][0] = *(const f32x4*)((const float*)base + o); bv[m][bj][1] = *(const f32x4*)((const float*)base + o + 4); } }
#pragma unroll
            for (int m = 0; m < 4; ++m) {
                float s = 0.f;
#pragma unroll
                for (int bj = 0; bj < 2; ++bj) {
                    const size_t o = (size_t)(tok0 + 128 * ai + 16 * m) * 1024 + c0 + 128 * bj;
                    f32x4 a, b;
                    if (BASE_BF) { const u32x4 z = bz[m][bj]; a = acc[ai][bj][m][0] + (f32x4){bflo(z.x), bfhi(z.x), bflo(z.y), bfhi(z.y)}; b = acc[ai][bj][m][1] + (f32x4){bflo(z.z), bfhi(z.z), bflo(z.w), bfhi(z.w)}; }
                    else { a = acc[ai][bj][m][0] + bv[m][bj][0]; b = acc[ai][bj][m][1] + bv[m][bj][1]; }
                    *(u32x4*)(H + o) = pack8(a, b);
                    s += (a[0] * a[0] + a[1] * a[1]) + (a[2] * a[2] + a[3] * a[3]) + (b[0] * b[0] + b[1] * b[1]) + (b[2] * b[2] + b[3] * b[3]);
                }
                s += __shfl_xor(s, 16); s += __shfl_xor(s, 32);
                sarr[ai * 4 + m] = s;
            }
        }
        if (fq == 0) {
#pragma unroll
            for (int i = 0; i < 8; ++i) RED[(64 * wr + fr + 128 * (i >> 2) + 16 * (i & 3)) * 4 + wc] = sarr[i];
        }
        asm volatile("s_waitcnt lgkmcnt(0)" ::: "memory"); __builtin_amdgcn_s_barrier(); asm volatile("" ::: "memory");
        const int tid = (wr * 4 + wc) * 64 + fq * 16 + fr;
        if (tid < 256) { const f32x4 r = *(const LAS f32x4*)(RED + tid * 4); ss[(size_t)(u.pm * 256 + tid) * 4 + u.pn] = (r[0] + r[1]) + (r[2] + r[3]); }
    }
};
struct EpiFinal {
    static constexpr bool PERM = false, HAS_PRE = false;
    const bf16_t* base; float* out; const float* gfin; float* xs; unsigned* cnt; LAS float* RED;
    __device__ __forceinline__ void operator()(const Acc& acc_in, const Unit& u, int wr, int wc, int fr, int fq) const {
        Acc& acc = const_cast<Acc&>(acc_in);
        const int c0 = 256 * u.pn + 32 * wc + 4 * fq, tok0 = u.pm * 256 + 64 * wr + fr, tid = (wr * 4 + wc) * 64 + fq * 16 + fr;
        float sarr[8];
#pragma unroll
        for (int ai = 0; ai < 2; ++ai) {
            u32x2 bz[4][2][2];
#pragma unroll
            for (int m = 0; m < 4; ++m)
#pragma unroll
                for (int bj = 0; bj < 2; ++bj)
#pragma unroll
                    for (int n = 0; n < 2; ++n) bz[m][bj][n] = *(const u32x2*)(base + (size_t)(tok0 + 128 * ai + 16 * m) * 1024 + c0 + 128 * bj + 16 * n);
#pragma unroll
            for (int m = 0; m < 4; ++m) {
                float s = 0.f;
#pragma unroll
                for (int bj = 0; bj < 2; ++bj) {
                    const u32x2 z0 = bz[m][bj][0], z1 = bz[m][bj][1];
                    const f32x4 a = acc[ai][bj][m][0] + (f32x4){bflo(z0.x), bfhi(z0.x), bflo(z0.y), bfhi(z0.y)}, b = acc[ai][bj][m][1] + (f32x4){bflo(z1.x), bfhi(z1.x), bflo(z1.y), bfhi(z1.y)};
                    acc[ai][bj][m][0] = a; acc[ai][bj][m][1] = b;
                    s += (a[0] * a[0] + a[1] * a[1]) + (a[2] * a[2] + a[3] * a[3]) + (b[0] * b[0] + b[1] * b[1]) + (b[2] * b[2] + b[3] * b[3]);
                }
                s += __shfl_xor(s, 16); s += __shfl_xor(s, 32);
                sarr[ai * 4 + m] = s;
            }
        }
        if (fq == 0) {
#pragma unroll
            for (int i = 0; i < 8; ++i) RED[(64 * wr + fr + 128 * (i >> 2) + 16 * (i & 3)) * 4 + wc] = sarr[i];
        }
        asm volatile("s_waitcnt lgkmcnt(0)" ::: "memory"); __builtin_amdgcn_s_barrier(); asm volatile("" ::: "memory");
        if (tid < 256) { const f32x4 r = *(const LAS f32x4*)(RED + tid * 4); xs[(size_t)(u.pm * 256 + tid) * 4 + u.pn] = (r[0] + r[1]) + (r[2] + r[3]); }
        asm volatile("s_waitcnt vmcnt(0)" ::: "memory"); __builtin_amdgcn_s_barrier(); asm volatile("" ::: "memory");
        if (tid == 0) {
            unsigned* c = cnt + (size_t)u.pm * 64;
            __builtin_amdgcn_fence(__ATOMIC_RELEASE, "agent");
            asm volatile("s_waitcnt vmcnt(0)" ::: "memory");
            (void)__hip_atomic_fetch_add(c, 1u, __ATOMIC_RELAXED, __HIP_MEMORY_SCOPE_AGENT);
            unsigned sp = 0u;
            while (__hip_atomic_load(c, __ATOMIC_RELAXED, __HIP_MEMORY_SCOPE_AGENT) < 4u) { __builtin_amdgcn_s_sleep(1); if (++sp > (1u << 22)) break; }
            __builtin_amdgcn_fence(__ATOMIC_ACQUIRE, "agent");
            asm volatile("s_waitcnt vmcnt(0)" ::: "memory");
        }
        __builtin_amdgcn_s_barrier(); asm volatile("" ::: "memory");
        if (tid < 256) { const f32x4 p = *(const f32x4*)(xs + (size_t)(u.pm * 256 + tid) * 4); RED[1024 + tid] = rsqrtf(((p[0] + p[1]) + (p[2] + p[3])) * (1.0f / DM) + EPS); }
        asm volatile("s_waitcnt lgkmcnt(0)" ::: "memory"); __builtin_amdgcn_s_barrier(); asm volatile("" ::: "memory");
        f32x4 gv[2][2];
#pragma unroll
        for (int bj = 0; bj < 2; ++bj) { gv[bj][0] = *(const f32x4*)(gfin + c0 + 128 * bj); gv[bj][1] = *(const f32x4*)(gfin + c0 + 128 * bj + 16); }
#pragma unroll
        for (int ai = 0; ai < 2; ++ai)
#pragma unroll
            for (int m = 0; m < 4; ++m) {
                const float rs = RED[1024 + 64 * wr + fr + 128 * ai + 16 * m];
#pragma unroll
                for (int bj = 0; bj < 2; ++bj) { float* op = out + (size_t)(tok0 + 128 * ai + 16 * m) * 1024 + c0 + 128 * bj;
                    *(f32x4*)op = acc[ai][bj][m][0] * rs * gv[bj][0]; *(f32x4*)(op + 16) = acc[ai][bj][m][1] * rs * gv[bj][1]; }
            }
    }
};
struct EpiUp {
    static constexpr bool PERM = true, HAS_PRE = true;
    __device__ __forceinline__ void pre(const Unit& u, int wid, int lane) const {
        if (wid < 4) {
            const int t = wid * 64 + lane, k = t >> 6, c = (t & 63) * 4, col = (c >> 7) * DFF + u.pn * 128 + (c & 127);
            const float* src = (k < 3) ? cw + (size_t)k * NUP + col : cb + col;
            __builtin_amdgcn_global_load_lds((const unsigned*)src, (LAS unsigned*)(X + 2048 + wid * 256), 16, 0, 0);
            __builtin_amdgcn_global_load_lds((const unsigned*)(ss + (size_t)(u.pm * 256 + t) * 4), (LAS unsigned*)(X + 3072 + wid * 256), 16, 0, 0);
        }
    }
    const float* ss; const float* cw; const float* cb; bf16_t* act; float* EB; LAS float* X;
    __device__ __forceinline__ void operator()(const Acc& acc_in, const Unit& u, int wr, int wc, int fr_, int fq_) const {
        Acc& acc = const_cast<Acc&>(acc_in);
        int lane = threadIdx.x & 63; asm volatile("" : "+v"(lane));
        const int fr = lane & 15, fq = lane >> 4, tid = (wr * 4 + wc) * 64 + lane;
        const int cl = 32 * wc + 8 * fq;
        LAS float* CST = X + 2048; LAS float* RSP = X + 3072; LAS float* RS = X + 4096;
        if (tid < 256) { const f32x4 r = *(const LAS f32x4*)(RSP + tid * 4); RS[tid] = rsqrtf(((r[0] + r[1]) + (r[2] + r[3])) * (1.0f / DM) + EPS); }
#pragma unroll
        for (int ai = 0; ai < 2; ++ai) {
            const int q = 2 * ai + wr;
#pragma unroll
            for (int bj = 0; bj < 2; ++bj)
#pragma unroll
                for (int n = 0; n < 2; ++n) {
                    const bool f0 = (fr == 0), f15 = (fr == 15);
                    f32x4 lo = acc[ai][bj][0][n], hi = acc[ai][bj][3][n], sv;
#pragma unroll
                    for (int e = 0; e < 4; ++e) sv[e] = f0 ? lo[e] : hi[e];
                    if (f0 || f15) *(LAS f32x4*)(X + (q * 2 + (f0 ? 0 : 1)) * 256 + 128 * bj + cl + 4 * n) = sv;
                }
        }
        asm volatile("s_waitcnt lgkmcnt(0)" ::: "memory");
        __builtin_amdgcn_s_barrier();
        asm volatile("" ::: "memory");
#pragma unroll
        for (int ai = 0; ai < 2; ++ai) {
            const int q = 2 * ai + wr;
#pragma unroll
            for (int m = 0; m < 4; ++m) {
                const float rs = RS[128 * ai + 64 * wr + 16 * m + fr];
#pragma unroll
                for (int bj = 0; bj < 2; ++bj)
#pragma unroll
                    for (int n = 0; n < 2; ++n) acc[ai][bj][m][n] = acc[ai][bj][m][n] * rs;
            }
#pragma unroll
            for (int bj = 0; bj < 2; ++bj)
#pragma unroll
                for (int n = 0; n < 2; ++n) {
                    const bool e0 = (q == 0 && fr < 2), e3 = (q == 3 && fr >= 14);
                    f32x4 lo = acc[ai][bj][0][n], hi = acc[ai][bj][3][n], ev;
#pragma unroll
                    for (int e = 0; e < 4; ++e) ev[e] = e0 ? lo[e] : hi[e];
                    const size_t ec = (size_t)bj * DFF + u.pn * 128 + cl + 4 * n;
                    if (e0 || e3) *(f32x4*)(EB + ((size_t)(u.pm * 4 + (e0 ? fr : fr - 12))) * NUP + ec) = ev;
                }
        }
#pragma unroll
        for (int n = 0; n < 2; ++n)
#pragma unroll
            for (int ep = 0; ep < 2; ++ep) {
                const int ci = cl + 4 * n + 2 * ep;
                if (ep == 0 && n == 0) __builtin_amdgcn_sched_barrier(0);
                f32x2 w0[2], w1[2], w2[2], bb[2];
#pragma unroll
                for (int bj = 0; bj < 2; ++bj) { w0[bj] = *(const LAS f32x2*)(CST + 128 * bj + ci); w1[bj] = *(const LAS f32x2*)(CST + 256 + 128 * bj + ci); w2[bj] = *(const LAS f32x2*)(CST + 512 + 128 * bj + ci); bb[bj] = *(const LAS f32x2*)(CST + 768 + 128 * bj + ci); }
#pragma unroll
                for (int ai = 0; ai < 2; ++ai) {
                    const int q = 2 * ai + wr;
                    f32x2 cv[2][4];
#pragma unroll
                    for (int bj = 0; bj < 2; ++bj) {
                        f32x2 top = *(const LAS f32x2*)(X + ((q > 0 ? q - 1 : 0) * 2 + 1) * 256 + 128 * bj + ci) * RS[q > 0 ? 64 * q - 1 : 0]; if (q == 0) top = (f32x2){0.f, 0.f};
                        f32x2 bot = *(const LAS f32x2*)(X + ((q < 3 ? q + 1 : 3) * 2 + 0) * 256 + 128 * bj + ci) * RS[q < 3 ? 64 * q + 64 : 255]; if (q == 3) bot = (f32x2){0.f, 0.f};
                        f32x2 v[4];
#pragma unroll
                        for (int m = 0; m < 4; ++m) v[m] = (f32x2){acc[ai][bj][m][n][2 * ep], acc[ai][bj][m][n][2 * ep + 1]};
#pragma unroll
                        for (int m = 0; m < 4; ++m) {
                            f32x2 pv, nv;
#pragma unroll
                            for (int c = 0; c < 2; ++c) {
                                const float po = (m == 0) ? top[c] : dpp_rot<0x121>(v[m > 0 ? m - 1 : 0][c]);
                                pv[c] = dpp_upd<0x111>(po, v[m][c]);
                                const float no = (m == 3) ? bot[c] : dpp_rot<0x12f>(v[m < 3 ? m + 1 : 3][c]);
                                nv[c] = dpp_upd<0x101>(no, v[m][c]);
                            }
                            cv[bj][m] = bb[bj] + w0[bj] * pv + w1[bj] * v[m] + w2[bj] * nv;
                        }
                    }
#pragma unroll
                    for (int m = 0; m < 4; ++m) { const f32x2 r = gelu_t2(cv[0][m]) * cv[1][m]; acc[ai][0][m][n][2 * ep] = r[0]; acc[ai][0][m][n][2 * ep + 1] = r[1]; }
                }
            }
#pragma unroll
        for (int ai = 0; ai < 2; ++ai)
#pragma unroll
            for (int m = 0; m < 4; ++m) {
                const int tok = u.pm * 256 + 128 * ai + 64 * wr + 16 * m + fr;
                *(u32x4*)(act + (size_t)tok * DFF + u.pn * 128 + cl) = pack8(acc[ai][0][m][0], acc[ai][0][m][1]);
            }
    }
};

__device__ __forceinline__ void s5_lam(const Params& P, int dir, int g, int p, float& ar, float& ai, float& lr, float& li) {
    const float dt = expf(P.log_dt[dir * 32 + g]); const int i = (dir * 32 + g) * 64 + p; lr = P.lam_re[i]; li = P.lam_im[i]; ar = lr * dt; ai = li * dt;
}
__device__ __forceinline__ void cpowf_(float ar, float ai, float e, float& re, float& im) { const float mg = expf(ar * e); float s, c; sincosf(ai * e, &s, &c); re = mg * c; im = mg * s; }
__device__ __forceinline__ void s5_coef(float ar, float ai, float lr, float li, float& cr, float& ci) {
    float s, c; sincosf(ai, &s, &c); const float em1 = expm1f(ar), sh = sinf(0.5f * ai);
    const float nr = em1 * c - 2.0f * sh * sh, ni = (em1 + 1.0f) * s, den = lr * lr + li * li;
    cr = (nr * lr + ni * li) / den; ci = (ni * lr - nr * li) / den;
}

__device__ __forceinline__ void p0_transposes(const Params& P, unsigned char* shm, const int tid, const int bid, const int gsz, const int sel) {
    unsigned char* ws = P.ws;
    bf16_t* WinT = (bf16_t*)(ws + O_WIN); bf16_t* WgluT = (bf16_t*)(ws + O_WGLU); bf16_t* WoutT = (bf16_t*)(ws + O_WOUT); bf16_t* WupT = (bf16_t*)(ws + O_WUP); bf16_t* WdnT = (bf16_t*)(ws + O_WDN);
    {
        float* tile = (float*)shm;
        constexpr int T0 = 16 * 8, T1 = 8 * 8, T2 = 8 * 16, T3 = 16 * 88, T4 = 44 * 16; const int TT = (sel == 1) ? T1 + T2 + T4 : (sel >= 2) ? T3 / 2 : T0;
        auto decode = [&](int vt, const float*& src, int& lds_, bf16_t*& dst, int& ldd, int& k0, int& n0, int& sn0, int& mode) {
            int r = (sel == 1) ? (vt < T1 + T2 ? T0 + vt : vt + T0 + T3) : (sel >= 2) ? vt + T0 + T1 + T2 + (sel == 3 ? T3 / 2 : 0) : vt, nkt; mode = 0;
            if (r < T0) { src = P.w_in; lds_ = 1024; dst = WinT; ldd = 1024; nkt = 16; }
            else if ((r -= T0) < T1) { src = P.w_glu; lds_ = 512; dst = WgluT; ldd = 512; nkt = 8; }
            else if ((r -= T1) < T2) { src = P.w_out; lds_ = 1024; dst = WoutT; ldd = 1024; nkt = 8; }
            else if ((r -= T2) < T3) { src = P.w_up; lds_ = NUP; dst = WupT; ldd = 1024; nkt = 16; mode = 1; }
            else { r -= T3; src = P.w_down; lds_ = 1024; dst = WdnT; ldd = DFF; nkt = 44; }
            k0 = (r % nkt) * 64; n0 = (r / nkt) * 64;
            sn0 = n0; if (mode == 1) { const int pn = n0 >> 8, bj = (n0 >> 7) & 1, r0 = n0 & 127; sn0 = bj * DFF + pn * 128 + r0; }
        };
        const int rr0 = tid >> 4, c4 = (tid & 15) * 4;
        f32x4 pv[2];
        { int it = bid; if (it < TT) { const float* src; int lds_, ldd, k0, n0, sn0, mode; bf16_t* dst; decode(it, src, lds_, dst, ldd, k0, n0, sn0, mode);
#pragma unroll
            for (int i = 0; i < 2; ++i) { pv[i] = *(const f32x4*)(src + (size_t)(k0 + rr0 + 32 * i) * lds_ + sn0 + c4); if (mode == 1) pv[i] = pv[i] * P.g_ffn[k0 + rr0 + 32 * i]; } } }
        for (int it = bid; it < TT; it += gsz) {
            const float* src; int lds_, ldd, k0, n0, sn0, mode; bf16_t* dst; decode(it, src, lds_, dst, ldd, k0, n0, sn0, mode);
            __syncthreads();
#pragma unroll
            for (int i = 0; i < 2; ++i) { const int rr = rr0 + 32 * i; tile[rr * 65 + c4] = pv[i][0]; tile[rr * 65 + c4 + 1] = pv[i][1]; tile[rr * 65 + c4 + 2] = pv[i][2]; tile[rr * 65 + c4 + 3] = pv[i][3]; }
            __syncthreads();
            if (it + gsz < TT) { const float* src2; int lds2, ldd2, k02, n02, sn02, mode2; bf16_t* dst2; decode(it + gsz, src2, lds2, dst2, ldd2, k02, n02, sn02, mode2);
#pragma unroll
                for (int i = 0; i < 2; ++i) { pv[i] = *(const f32x4*)(src2 + (size_t)(k02 + rr0 + 32 * i) * lds2 + sn02 + c4); if (mode2 == 1) pv[i] = pv[i] * P.g_ffn[k02 + rr0 + 32 * i]; } }
            { const int nl = tid >> 3, kc = (tid & 7) * 8; const float* tp = tile + kc * 65 + nl;
                u32x4 w; w.x = cvt_pk_bf16(tp[0], tp[65]); w.y = cvt_pk_bf16(tp[2 * 65], tp[3 * 65]); w.z = cvt_pk_bf16(tp[4 * 65], tp[5 * 65]); w.w = cvt_pk_bf16(tp[6 * 65], tp[7 * 65]);
                *(u32x4*)(dst + (size_t)(n0 + nl) * ldd + k0 + kc) = w; }
        }
        __syncthreads();
    }
}
__device__ __forceinline__ void p0_c2(const Params& P, unsigned char* shm, const int tid, const int bid, const int gsz) {
    bf16_t* WoutT = (bf16_t*)(P.ws + O_WOUT);
    {
        float* wo = (float*)shm; float* wfT = wo + 128 * 64;
        for (int it = bid; it < 64; it += gsz) {
            const int h = it >> 4, n0 = (it & 15) * 64;
            __syncthreads();
            for (int i = 0; i < 4; ++i) { const int idx = (tid + 512 * i) * 4, d = idx >> 6, n = idx & 63; *(f32x4*)(wo + idx) = *(const f32x4*)(P.w_out + (size_t)(512 + h * 128 + d) * 1024 + n0 + n); }
            for (int i = 0; i < 32; ++i) { const int idx = tid + 512 * i, d = idx >> 7, c = idx & 127; wfT[idx] = P.w_fourier[(size_t)(h * 128 + c) * 128 + d]; }
            __syncthreads();
            const int c0 = (tid & 31) * 4, nn = (tid >> 5) * 4; f32x4 a[4];
#pragma unroll
            for (int i = 0; i < 4; ++i) a[i] = (f32x4){0.f, 0.f, 0.f, 0.f};
            for (int d = 0; d < 128; ++d) { const f32x4 f = *(const f32x4*)(wfT + d * 128 + c0), w = *(const f32x4*)(wo + d * 64 + nn);
#pragma unroll
                for (int i = 0; i < 4; ++i) a[i] += w[i] * f; }
#pragma unroll
            for (int i = 0; i < 4; ++i) { u32x2 w; w.x = cvt_pk_bf16(a[i][0], a[i][1]); w.y = cvt_pk_bf16(a[i][2], a[i][3]); *(u32x2*)(WoutT + (size_t)(n0 + nn + i) * 1024 + 512 + h * 128 + c0) = w; }
        }
        __syncthreads();
    }
}

__device__ __forceinline__ void phase0(const Params& P, unsigned char* shm, const int bid, const int gsz) {
    unsigned char* ws = P.ws;
    int tid_ = threadIdx.x; asm volatile("" : "+v"(tid_));
    const int tid = tid_, wid = tid >> 6, lane = tid & 63;
    const int gtid = bid * 512 + tid, nthr = gsz * 512;
    bf16_t* WinT = (bf16_t*)(ws + O_WIN); bf16_t* WgluT = (bf16_t*)(ws + O_WGLU); bf16_t* WoutT = (bf16_t*)(ws + O_WOUT); bf16_t* WupT = (bf16_t*)(ws + O_WUP); bf16_t* WdnT = (bf16_t*)(ws + O_WDN);
    auto rmsnorm_rows = [&]()     {
        bf16_t* xn = (bf16_t*)(ws + O_XN);
        f32x4 gm[4];
#pragma unroll
        for (int i = 0; i < 4; ++i) gm[i] = ((const f32x4*)P.g_mix)[lane + 64 * i];
        for (int row0 = (bid * 8 + wid) * 4; row0 < NTOK; row0 += gsz * 8 * 4) {
            f32x4 v[4][4];
#pragma unroll
            for (int r = 0; r < 4; ++r)
#pragma unroll
                for (int i = 0; i < 4; ++i) v[r][i] = ((const f32x4*)(P.x + (size_t)(row0 + r) * DM))[lane + 64 * i];
#pragma unroll
            for (int r = 0; r < 4; ++r) {
                float s = 0.f;
#pragma unroll
                for (int i = 0; i < 4; ++i) s += (v[r][i][0] * v[r][i][0] + v[r][i][1] * v[r][i][1]) + (v[r][i][2] * v[r][i][2] + v[r][i][3] * v[r][i][3]);
#pragma unroll
                for (int o = 32; o; o >>= 1) s += __shfl_xor(s, o);
                const float rs = rsqrtf(s * (1.0f / DM) + EPS);
#pragma unroll
                for (int i = 0; i < 4; ++i) { const f32x4 t = v[r][i] * rs * gm[i]; u32x2 w; w.x = cvt_pk_bf16(t[0], t[1]); w.y = cvt_pk_bf16(t[2], t[3]);
                    *(u32x2*)(xn + (size_t)(row0 + r) * DM + (lane + 64 * i) * 4) = w; }
            }
        }
    };
    if (bid & 1) rmsnorm_rows();
    p0_transposes(P, shm, tid, bid, gsz, 0);
    {
        float* wt = (float*)shm; float* cs = wt + 16 * 128; float* sn = cs + 128;
        for (int it = bid; it < 256; it += gsz) {
            const int h = it >> 6, k0 = (it & 63) * 16;
            __syncthreads();
            if (tid < 128) { float s, c; sincospif((float)tid * (1.0f / 64.0f), &s, &c); cs[tid] = c * 0.08838834764831845f; sn[tid] = s * 0.08838834764831845f; }
            { const int row = tid >> 5, c4 = tid & 31; *(f32x4*)(wt + row * 128 + c4 * 4) = *(const f32x4*)(P.w_in + (size_t)(k0 + row) * 1024 + 512 + h * 128 + c4 * 4); }
            __syncthreads();
            const int r = tid & 127, ks = tid >> 7, j = (r <= 64) ? r : r - 64; const float* tb = (r <= 64) ? cs : sn;
            float a[4];
#pragma unroll
            for (int kk = 0; kk < 4; ++kk) a[kk] = 0.f;
            for (int c = 0; c < 128; c += 4) { const float t0 = tb[(c * j) & 127], t1 = tb[((c + 1) * j) & 127], t2 = tb[((c + 2) * j) & 127], t3 = tb[((c + 3) * j) & 127];
#pragma unroll
                for (int kk = 0; kk < 4; ++kk) { const f32x4 w4 = *(const f32x4*)(wt + (ks * 4 + kk) * 128 + c); a[kk] += (w4[0] * t0 + w4[1] * t1) + (w4[2] * t2 + w4[3] * t3); } }
            u32x2 w; w.x = cvt_pk_bf16(a[0], a[1]); w.y = cvt_pk_bf16(a[2], a[3]);
            *(u32x2*)(WinT + (size_t)(512 + h * 128 + r) * 1024 + k0 + ks * 4) = w;
        }
        __syncthreads();
    }
    {
        bf16_t* AL = (bf16_t*)(ws + O_AL); float* tab = (float*)shm;
        __syncthreads();
        for (int i = tid; i < 2048; i += 512) tab[i] = cospif((float)i * (1.0f / 1024.0f)) * 0.02209708691207961f;
        __syncthreads();
        for (int it = gtid; it < (1 << 19); it += nthr) {
            const int l8 = (it & 255) * 8, k = (it >> 8) & 1023, sc = it >> 18; float v[8];
#pragma unroll
            for (int e = 0; e < 8; ++e) v[e] = tab[(k * (l8 + e) - (sc ? 512 : 0)) & 2047];
            u32x4 w; w.x = cvt_pk_bf16(v[0], v[1]); w.y = cvt_pk_bf16(v[2], v[3]); w.z = cvt_pk_bf16(v[4], v[5]); w.w = cvt_pk_bf16(v[6], v[7]);
            *(u32x4*)(AL + ((size_t)(sc * 1024 + k)) * 2048 + l8) = w;
        }
        __syncthreads();
    }
    {
        bf16_t* Wst = (bf16_t*)(ws + O_WST); bf16_t* Wy = (bf16_t*)(ws + O_WY); float* Kt = (float*)(ws + O_KTAB);
        float* Lr = (float*)shm; float* Li = Lr + 33 * 64; float* Fr = Li + 33 * 64; float* Fi = Fr + 64; float* Cr = Fi + 64; float* Ci = Cr + 1024; float* Br = Ci + 1024; float* Bi = Br + 1024;
        for (int it = bid; it < 256; it += gsz) {
            const int qt = it & 3, dir = (it >> 2) & 1, g = it >> 3;
            __syncthreads();
            { const int p = tid & 63, dl = tid >> 6; float ar, ai, lr, li; s5_lam(P, dir, g, p, ar, ai, lr, li);
              for (int e = dl; e < 33; e += 8) { float pr, pi; cpowf_(ar, ai, (float)e, pr, pi); Lr[e * 64 + p] = pr; Li[e * 64 + p] = pi; }
              if (dl == 0) { float cr, ci; s5_coef(ar, ai, lr, li, cr, ci); Fr[p] = cr; Fi[p] = ci; }
              const size_t cb0 = (size_t)(dir * 32 + g) * 1024;
#pragma unroll
              for (int i = 0; i < 2; ++i) { const int idx = tid + 512 * i; Cr[idx] = P.c_re[cb0 + idx]; Ci[idx] = P.c_im[cb0 + idx]; Br[idx] = P.b_re[cb0 + idx]; Bi[idx] = P.b_im[cb0 + idx]; } }
            __syncthreads();
#pragma unroll
            for (int j = 0; j < 2; ++j) {
                const int idx = tid + 512 * j, sl = idx & 7, rowi = idx >> 3, part = rowi >> 6, p = rowi & 63, s = qt * 8 + sl, e = dir ? s : 31 - s;
                const float Er = Lr[e * 64 + p] * Fr[p] - Li[e * 64 + p] * Fi[p], Ei = Lr[e * 64 + p] * Fi[p] + Li[e * 64 + p] * Fr[p];
                float o[16];
#pragma unroll
                for (int h = 0; h < 16; ++h) o[h] = part ? (Er * Bi[p * 16 + h] + Ei * Br[p * 16 + h]) : (Er * Br[p * 16 + h] - Ei * Bi[p * 16 + h]);
                u32x4 w0, w1; w0.x = cvt_pk_bf16(o[0], o[1]); w0.y = cvt_pk_bf16(o[2], o[3]); w0.z = cvt_pk_bf16(o[4], o[5]); w0.w = cvt_pk_bf16(o[6], o[7]);
                w1.x = cvt_pk_bf16(o[8], o[9]); w1.y = cvt_pk_bf16(o[10], o[11]); w1.z = cvt_pk_bf16(o[12], o[13]); w1.w = cvt_pk_bf16(o[14], o[15]);
                u32x4* d = (u32x4*)(Wst + ((size_t)(g * 256 + dir * 128 + rowi)) * 512 + s * 16); d[0] = w0; d[1] = w1;
            }
            { const int p = tid & 63, t = qt * 8 + (tid >> 6), e = dir ? 32 - t : t + 1; const float pr = Lr[e * 64 + p], pi = Li[e * 64 + p];
#pragma unroll
              for (int h = 0; h < 16; ++h) { const float cr = Cr[h * 64 + p], ci = Ci[h * 64 + p]; bf16_t* d = Wy + ((size_t)(g * 512 + t * 16 + h)) * UK + 512 + dir * 128 + p;
                  d[0] = f2bf(cr * pr - ci * pi); d[64] = f2bf(-(cr * pi + ci * pr)); } }
            { const int o = tid & 255, h = o >> 4, h2 = o & 15, dh = tid >> 8; float a[4] = {0.f, 0.f, 0.f, 0.f};
              for (int p = 0; p < 64; ++p) {
                  const float cr = Cr[h * 64 + p], ci = Ci[h * 64 + p], xr = cr * Fr[p] - ci * Fi[p], xi = cr * Fi[p] + ci * Fr[p];
                  const float br = Br[p * 16 + h2], bi = Bi[p * 16 + h2], mr = xr * br - xi * bi, mi = xr * bi + xi * br;
#pragma unroll
                  for (int j = 0; j < 4; ++j) { const int d = qt * 8 + dh * 4 + j; a[j] += mr * Lr[d * 64 + p] - mi * Li[d * 64 + p]; }
              }
#pragma unroll
              for (int j = 0; j < 4; ++j) Kt[((size_t)((g * 2 + dir) * 32 + qt * 8 + dh * 4 + j)) * 256 + o] = a[j]; }
        }
        __syncthreads();
    }
    if (!(bid & 1)) rmsnorm_rows();
}

__device__ __forceinline__ void phase3(const Params& P, const int bid, const int gsz) {
    int tid_ = threadIdx.x; asm volatile("" : "+v"(tid_));
    unsigned char* ws = P.ws; const int gtid = bid * 512 + tid_, nthr = gsz * 512;
    bf16_t* U = (bf16_t*)(ws + O_U); const float* S = (const float*)(ws + O_SLOC);
    for (int it = gtid; it < 32 * 16 * 2 * 64; it += nthr) {
        const int p = it & 63, dir = (it >> 6) & 1, b = (it >> 7) & 15, g = it >> 11;
        float ar, ai, lr, li, tr, ti; s5_lam(P, dir, g, p, ar, ai, lr, li); cpowf_(ar, ai, 32.0f, tr, ti);
        float hr = 0.f, hi = 0.f;
        for (int c0 = 0; c0 < 64; c0 += 16) {
            float sr[16], si[16];
#pragma unroll
            for (int j = 0; j < 16; ++j) { const int c = dir ? 63 - (c0 + j) : c0 + j; const float* sp = S + ((size_t)(g * 1024 + b * 64 + c)) * 256 + dir * 128 + p; sr[j] = sp[0]; si[j] = sp[64]; }
#pragma unroll
            for (int j = 0; j < 16; ++j) { const int c = dir ? 63 - (c0 + j) : c0 + j; bf16_t* up = U + ((size_t)(g * 1024 + b * 64 + c)) * UK + 512 + dir * 128 + p;
                up[0] = f2bf(hr); up[64] = f2bf(hi);
                const float nr = tr * hr - ti * hi + sr[j], ni = tr * hi + ti * hr + si[j]; hr = nr; hi = ni; }
        }
    }
    {
        const bf16_t* EO = (const bf16_t*)(ws + O_Z); bf16_t* cat = (bf16_t*)(ws + O_CAT); const bf16_t* PT = (const bf16_t*)(ws + O_PQT);
        for (int it = gtid; it < 1024 * 64 * 8; it += nthr) {
            const int j0 = (it & 7) * 8, bh = (it >> 3) & 63, k = it >> 9, b = bh >> 2, h = bh & 3;
            const u32x4 e = *(const u32x4*)(EO + (size_t)k * 4352 + bh * 64 + j0); u32x4 o = *(const u32x4*)(EO + ((size_t)(1024 + k)) * 4352 + bh * 64 + j0);
            if (j0 == 0) o.x &= 0xffff0000u;
            float lo[8], hi[8];
            lo[0] = bflo(e.x) - bflo(o.x); hi[0] = bflo(e.x) + bflo(o.x); lo[1] = bfhi(e.x) - bfhi(o.x); hi[1] = bfhi(e.x) + bfhi(o.x);
            lo[2] = bflo(e.y) - bflo(o.y); hi[2] = bflo(e.y) + bflo(o.y); lo[3] = bfhi(e.y) - bfhi(o.y); hi[3] = bfhi(e.y) + bfhi(o.y);
            lo[4] = bflo(e.z) - bflo(o.z); hi[4] = bflo(e.z) + bflo(o.z); lo[5] = bfhi(e.z) - bfhi(o.z); hi[5] = bfhi(e.z) + bfhi(o.z);
            lo[6] = bflo(e.w) - bflo(o.w); hi[6] = bflo(e.w) + bflo(o.w); lo[7] = bfhi(e.w) - bfhi(o.w); hi[7] = bfhi(e.w) + bfhi(o.w);
            bf16_t* ra = cat + ((size_t)(b * 2048 + k)) * 1024 + 512 + h * 128; bf16_t* rb = cat + ((size_t)(b * 2048 + 2048 - k)) * 1024 + 512 + h * 128;
            u32x4 wl, wh; wl.x = cvt_pk_bf16(lo[0], lo[1]); wl.y = cvt_pk_bf16(lo[2], lo[3]); wl.z = cvt_pk_bf16(lo[4], lo[5]); wl.w = cvt_pk_bf16(lo[6], lo[7]);
            wh.x = cvt_pk_bf16(hi[0], hi[1]); wh.y = cvt_pk_bf16(hi[2], hi[3]); wh.z = cvt_pk_bf16(hi[4], hi[5]); wh.w = cvt_pk_bf16(hi[6], hi[7]);
            *(u32x4*)(ra + j0) = wl;
            if (k > 0) *(u32x4*)(rb + j0) = wh;
#pragma unroll
            for (int i = 0; i < 8; ++i) { const int j = j0 + i; if (j > 0) { ra[128 - j] = f2bf(hi[i]); if (k > 0) rb[128 - j] = f2bf(lo[i]); } }
        }
        for (int it = gtid; it < 1024 * 64; it += nthr) {
            const int bh = it & 63, k = it >> 6, b = bh >> 2, h = bh & 3; const bf16_t v = EO[(size_t)k * 4352 + 4096 + bh];
            cat[((size_t)(b * 2048 + k)) * 1024 + 512 + h * 128 + 64] = v;
            if (k > 0) cat[((size_t)(b * 2048 + 2048 - k)) * 1024 + 512 + h * 128 + 64] = v;
        }
    }
}

__device__ __forceinline__ void phase2x(const Params& P, const int bid, const int gsz) {
    int tid_ = threadIdx.x; asm volatile("" : "+v"(tid_));
    unsigned char* ws = P.ws; const int gtid = bid * 512 + tid_, nthr = gsz * 512;
    {
        bf16_t* cat = (bf16_t*)(ws + O_CAT); const bf16_t* PT = (const bf16_t*)(ws + O_PQT);
        const int wid = tid_ >> 6, lane = tid_ & 63;
        for (int n = bid * 8 + wid; n < 64 * 65; n += gsz * 8) {
            const int bh = n / 65, j = n % 65, b = bh >> 2, h = bh & 3;
            const u32x4* pp = (const u32x4*)(PT + ((size_t)(j < 64 ? bh * 64 + j : 4096 + bh)) * 2048); float s = 0.f;
#pragma unroll
            for (int i = 0; i < 4; ++i) { const u32x4 v = pp[lane + 64 * i]; s += (bflo(v.x) - bfhi(v.x)) + (bflo(v.y) - bfhi(v.y)) + (bflo(v.z) - bfhi(v.z)) + (bflo(v.w) - bfhi(v.w)); }
#pragma unroll
            for (int o = 32; o; o >>= 1) s += __shfl_xor(s, o);
            if (lane == 0) { const bf16_t v = f2bf(s * 0.02209708691207961f); bf16_t* rr = cat + ((size_t)(b * 2048 + 1024)) * 1024 + 512 + h * 128; rr[j] = v; if (j > 0 && j < 64) rr[128 - j] = v; }
        }
    }
    bf16_t* Wy = (bf16_t*)(ws + O_WY); const float* Kt = (const float*)(ws + O_KTAB);
    for (int it = gtid; it < 32 * 32 * 16 * 32; it += nthr) {
        const int s = it & 31, h = (it >> 5) & 15, t = (it >> 9) & 31, g = it >> 14;
        float o[16];
        if (s < t) { const float* k = Kt + ((size_t)((g * 2 + 0) * 32 + (t - s))) * 256 + h * 16;
#pragma unroll
            for (int j = 0; j < 16; ++j) o[j] = k[j]; }
        else if (s > t) { const float* k = Kt + ((size_t)((g * 2 + 1) * 32 + (s - t))) * 256 + h * 16;
#pragma unroll
            for (int j = 0; j < 16; ++j) o[j] = k[j]; }
        else { const float* k0 = Kt + ((size_t)((g * 2 + 0) * 32)) * 256 + h * 16; const float* k1 = Kt + ((size_t)((g * 2 + 1) * 32)) * 256 + h * 16; const float dd = P.ssm_d[g * 16 + h];
#pragma unroll
            for (int j = 0; j < 16; ++j) o[j] = k0[j] + k1[j] + (j == h ? dd : 0.f); }
        u32x4 w0, w1; w0.x = cvt_pk_bf16(o[0], o[1]); w0.y = cvt_pk_bf16(o[2], o[3]); w0.z = cvt_pk_bf16(o[4], o[5]); w0.w = cvt_pk_bf16(o[6], o[7]);
        w1.x = cvt_pk_bf16(o[8], o[9]); w1.y = cvt_pk_bf16(o[10], o[11]); w1.z = cvt_pk_bf16(o[12], o[13]); w1.w = cvt_pk_bf16(o[14], o[15]);
        u32x4* d = (u32x4*)(Wy + ((size_t)(g * 512 + t * 16 + h)) * UK + s * 16); d[0] = w0; d[1] = w1;
    }
}

__device__ __forceinline__ void phase8(const Params& P, const int bid, const int gsz) {
    int tid_ = threadIdx.x; asm volatile("" : "+v"(tid_));
    unsigned char* ws = P.ws; const int gtid = bid * 512 + tid_, nthr = gsz * 512;
    const float* EB = (const float*)(ws + O_EB); bf16_t* act = (bf16_t*)(ws + O_ACT);
    for (int it = gtid; it < 128 * NUP; it += nthr) {
        const int pm = it / NUP, rem = it % NUP, which = rem / DFF, ch = rem % DFF;
        if ((pm & 7) == 7) continue;
        const float* e0 = EB + (size_t)(pm * 4) * NUP; const float* e1 = EB + (size_t)((pm + 1) * 4) * NUP;
        const float* rp = which ? e0 + 3 * NUP : e0 + 2 * NUP; const float* rc = which ? e1 : e0 + 3 * NUP; const float* rn = which ? e1 + NUP : e1;
        float cv[2];
#pragma unroll
        for (int bj = 0; bj < 2; ++bj) { const int col = bj * DFF + ch; cv[bj] = P.conv_b[col] + P.conv_w[col] * rp[col] + P.conv_w[NUP + col] * rc[col] + P.conv_w[2 * NUP + col] * rn[col]; }
        act[(size_t)(pm * 256 + 255 + which) * DFF + ch] = f2bf(gelu_t(cv[0]) * cv[1]);
    }
}

__device__ __forceinline__ void phase10(const Params& P, const int bid, const int gsz) {
    int tid_ = threadIdx.x; asm volatile("" : "+v"(tid_));
    const int wid = tid_ >> 6, lane = tid_ & 63; const float* ss = (const float*)(P.ws + O_SS2); const bf16_t* H2 = (const bf16_t*)(P.ws + O_CAT);
    for (int row = bid * 8 + wid; row < NTOK; row += gsz * 8) {
        const u32x4* p = (const u32x4*)(H2 + (size_t)row * DM); f32x4* d = (f32x4*)(P.out + (size_t)row * DM);
        float s = (lane < 4) ? ss[(size_t)row * 4 + lane] : 0.f;
#pragma unroll
        for (int o = 32; o; o >>= 1) s += __shfl_xor(s, o);
        const float rs = rsqrtf(s * (1.0f / DM) + EPS);
#pragma unroll
        for (int i = 0; i < 2; ++i) { const u32x4 z = p[lane + 64 * i]; const f32x4 g0 = ((const f32x4*)P.g_final)[(lane + 64 * i) * 2], g1 = ((const f32x4*)P.g_final)[(lane + 64 * i) * 2 + 1];
            d[(lane + 64 * i) * 2] = (f32x4){bflo(z.x), bfhi(z.x), bflo(z.y), bfhi(z.y)} * rs * g0; d[(lane + 64 * i) * 2 + 1] = (f32x4){bflo(z.z), bfhi(z.z), bflo(z.w), bfhi(z.w)} * rs * g1; }
    }
}

struct EpiNull {
    static constexpr bool PERM = true, HAS_PRE = false;
    float* dummy;
    __device__ __forceinline__ void operator()(const Acc& acc, const Unit& u, int wr, int wc, int fr, int fq) const {
        f32x4 s = {0.f, 0.f, 0.f, 0.f};
#pragma unroll
        for (int ai = 0; ai < 2; ++ai)
#pragma unroll
            for (int bj = 0; bj < 2; ++bj)
#pragma unroll
                for (int m = 0; m < 4; ++m)
#pragma unroll
                    for (int n = 0; n < 2; ++n) s += acc[ai][bj][m][n];
        if (s[0] + s[1] + s[2] + s[3] == 12345.678f) dummy[threadIdx.x] = s[0];
    }
};

__device__ __forceinline__ void run_phase(const Params& P0, int ph, const bool dummy, unsigned char* shm) {
    Params P = P0;
#define OPAQUE_G(p) do { __attribute__((address_space(1))) char* _g = (__attribute__((address_space(1))) char*)(p); asm volatile("" : "+s"(_g)); p = (decltype(p))_g; } while (0)
    OPAQUE_G(P.x); OPAQUE_G(P.g_mix); OPAQUE_G(P.w_in); OPAQUE_G(P.lam_re); OPAQUE_G(P.lam_im); OPAQUE_G(P.log_dt); OPAQUE_G(P.b_re); OPAQUE_G(P.b_im); OPAQUE_G(P.c_re); OPAQUE_G(P.c_im); OPAQUE_G(P.ssm_d); OPAQUE_G(P.w_glu);
    OPAQUE_G(P.b_glu); OPAQUE_G(P.w_fourier); OPAQUE_G(P.w_out); OPAQUE_G(P.g_ffn); OPAQUE_G(P.w_up); OPAQUE_G(P.conv_w); OPAQUE_G(P.conv_b); OPAQUE_G(P.w_down); OPAQUE_G(P.g_final); OPAQUE_G(P.out); OPAQUE_G(P.ws);
#undef OPAQUE_G
    int bid = blockIdx.x, gsz = gridDim.x; asm volatile("" : "+s"(bid), "+s"(gsz));
    unsigned char* ws = P.ws; LAS unsigned char* lds = (LAS unsigned char*)shm;
    Order S; S.G = gsz; S.c = bid; S.nBatch = 1; S.bA = 0; S.bB = 0;
    switch (ph) {
    case 0: phase0(P, shm, bid, gsz); break;
    case 1: { S.A = (const char*)(ws + O_XN); S.B = (const char*)(ws + O_WIN); S.nM = 128; S.nN = 4; S.sA = (size_t)256 * 1024 * 2; S.sB = (size_t)256 * 1024 * 2;

#if defined(REPEAT_PH) && PROBE_NULL && (REPEAT_PH == 1)
        if (dummy) { EpiNull E0{(float*)(ws + O_EB)}; gemm_phase(lds, 1024, 1024, 1024, S, E0); break; }
#endif
        EpiIn E{(bf16_t*)(ws + O_U), (bf16_t*)(ws + O_PQT)}; gemm_phase(lds, 1024, 1024, 1024, S, E); } break;
    case 2: { S.A = (const char*)(ws + O_U); S.B = (const char*)(ws + O_WST); S.nM = 4; S.nN = 1; S.nBatch = 32; S.bA = (size_t)1024 * UK * 2; S.bB = (size_t)256 * 512 * 2; S.sA = (size_t)256 * UK * 2; S.sB = (size_t)256 * 512 * 2;
        EpiSloc E{(float*)(ws + O_SLOC)}; gemm_phase(lds, 512, UK, 512, S, E);
        Order S2; S2.G = gsz; S2.c = (gsz >= 136) ? (bid + 136) % gsz : bid; S2.nBatch = 2; S2.bA = (size_t)1024 * 2048 * 2; S2.bB = (size_t)4352 * 2048 * 2; S2.A = (const char*)(ws + O_AL); S2.B = (const char*)(ws + O_PQT); S2.nM = 4; S2.nN = 17; S2.sA = (size_t)256 * 2048 * 2; S2.sB = (size_t)256 * 2048 * 2;
        EpiDft E2{(bf16_t*)(ws + O_Z)}; gemm_phase(lds, 2048, 2048, 2048, S2, E2);
        { int tid_ = threadIdx.x; asm volatile("" : "+v"(tid_));
          if (gsz >= 200) { if (bid < gsz - 136) { phase2x(P, bid, gsz - 136); p0_transposes(P, shm, tid_, bid, gsz - 136, 1); p0_c2(P, shm, tid_, bid, gsz - 136); } }
          else { phase2x(P, bid, gsz); p0_transposes(P, shm, tid_, bid, gsz, 1); p0_c2(P, shm, tid_, bid, gsz); } } } break;
    case 3: phase3(P, bid, gsz); break;
    case 4: { S.A = (const char*)(ws + O_U); S.B = (const char*)(ws + O_WY); S.nM = 4; S.nN = 2; S.nBatch = 32; S.bA = (size_t)1024 * UK * 2; S.bB = (size_t)512 * UK * 2; S.sA = (size_t)256 * UK * 2; S.sB = (size_t)256 * UK * 2;
        EpiY E{(bf16_t*)(ws + O_Z)}; gemm_phase(lds, UK, UK, UK, S, E); } break;
    case 5: { S.A = (const char*)(ws + O_Z); S.B = (const char*)(ws + O_WGLU); S.nM = 128; S.nN = 2; S.sA = (size_t)256 * 512 * 2; S.sB = (size_t)256 * 512 * 2;
        EpiGlu E{(const bf16_t*)(ws + O_Z), P.b_glu, (bf16_t*)(ws + O_CAT)}; gemm_phase(lds, 512, 512, 512, S, E); } break;
    case 6: { S.A = (const char*)(ws + O_CAT); S.B = (const char*)(ws + O_WOUT); S.nM = 128; S.nN = 4; S.sA = (size_t)256 * 1024 * 2; S.sB = (size_t)256 * 1024 * 2;

#if defined(REPEAT_PH) && PROBE_NULL && (REPEAT_PH == 6)
        if (dummy) { EpiNull E0{(float*)(ws + O_EB)}; gemm_phase(lds, 1024, 1024, 1024, S, E0); break; }
#endif
        { int tid_ = threadIdx.x; asm volatile("" : "+v"(tid_));
          const bool stag = (gsz & 1) == 0;
          if (!stag) { p0_transposes(P, shm, tid_, bid, gsz, 2); p0_transposes(P, shm, tid_, bid, gsz, 3); }
          else if (bid & 1) p0_transposes(P, shm, tid_, bid >> 1, gsz >> 1, 2);
          EpiRes<false> E{P.x, (bf16_t*)(ws + O_XN), (float*)(ws + O_SS1), (LAS float*)(lds + STAGE_BYTES)}; gemm_phase(lds, 1024, 1024, 1024, S, E);
          if (stag && !(bid & 1)) p0_transposes(P, shm, tid_, bid >> 1, gsz >> 1, 3); } } break;
    case 7: { S.A = (const char*)(ws + O_XN); S.B = (const char*)(ws + O_WUP); S.nM = 128; S.nN = 22; S.sA = (size_t)256 * 1024 * 2; S.sB = (size_t)256 * 1024 * 2;
#if defined(REPEAT_PH) && PROBE_NULL && (REPEAT_PH == 7)
        if (dummy) { EpiNull E{(float*)(ws + O_EB)}; gemm_phase(lds, 1024, 1024, 1024, S, E); break; }
#endif
        EpiUp E{(const float*)(ws + O_SS1), P.conv_w, P.conv_b, (bf16_t*)(ws + O_ACT), (float*)(ws + O_EB), (LAS float*)(lds + STAGE_BYTES)}; gemm_phase(lds, 1024, 1024, 1024, S, E); } break;
    case 8: phase8(P, bid, gsz); break;
    case 9: { S.A = (const char*)(ws + O_ACT); S.B = (const char*)(ws + O_WDN); S.nM = 128; S.nN = 4; S.sA = (size_t)256 * DFF * 2; S.sB = (size_t)256 * DFF * 2;

#if defined(REPEAT_PH) && PROBE_NULL && (REPEAT_PH == 9)
        if (dummy) { EpiNull E0{(float*)(ws + O_EB)}; gemm_phase(lds, DFF, DFF, DFF, S, E0); break; }
#endif
        if (gsz == 256) { EpiFinal EF{(const bf16_t*)(ws + O_XN), P.out, P.g_final, (float*)(ws + O_SS2), (unsigned*)(ws + O_BAR + 16384), (LAS float*)(lds + STAGE_BYTES)}; gemm_phase(lds, DFF, DFF, DFF, S, EF); break; }
        EpiRes<true> E{(const void*)(ws + O_XN), (bf16_t*)(ws + O_CAT), (float*)(ws + O_SS2), (LAS float*)(lds + STAGE_BYTES)}; gemm_phase(lds, DFF, DFF, DFF, S, E); } break;
    case 10: if (gsz != 256) phase10(P, bid, gsz); break;
    }
}


#define XB_TMO      128
#define XB_XCNT(j)  (256  + 64 * (j))
#define XB_XSUB(j)  (1280 + 64 * (j))
#define XB_XGEN(j)  (2304 + 64 * (j))
#define XB_TOP      3328
#define XB_TOPGEN   3392
#define XCD_BAR_WORDS 3456
#define XB_SPIN_CAP (1u << 22)
__device__ __forceinline__ unsigned xb_ld(unsigned* p)              { return __hip_atomic_load(p, __ATOMIC_RELAXED, __HIP_MEMORY_SCOPE_AGENT); }
__device__ __forceinline__ unsigned xb_add(unsigned* p, unsigned v) { return __hip_atomic_fetch_add(p, v, __ATOMIC_RELAXED, __HIP_MEMORY_SCOPE_AGENT); }
__device__ __forceinline__ unsigned xb_xcc_id() { return (unsigned)__builtin_amdgcn_s_getreg((3 << 11) | 20) & 0xFu; }
#define XB_SPIN(cond, bar) do { unsigned _sp = 0; while (cond) { __builtin_amdgcn_s_sleep(1); \
    if ((++_sp & 255u) == 0u) { if (xb_ld(&(bar)[XB_TMO])) break; if (_sp > XB_SPIN_CAP) { atomicAdd(&(bar)[XB_TMO], 1u); break; } } } } while (0)
struct XcdBarrier { unsigned* bar; unsigned x; volatile LAS unsigned* st; };
__device__ __forceinline__ XcdBarrier xcd_barrier_post(unsigned* bar, volatile LAS unsigned* st) {
    XcdBarrier b; b.bar = bar; b.x = xb_xcc_id(); b.st = st;
    if (threadIdx.x == 0) (void)xb_add(&bar[XB_XCNT(b.x)], 1u);
    return b;
}
__device__ __forceinline__ void xcd_barrier_complete(unsigned* bar, unsigned x, unsigned& nloc, unsigned& nx) {
    const unsigned G = gridDim.x * gridDim.y * gridDim.z;
    unsigned sum, cnt, mine, sp = 0u;
    for (;;) {
        sum = 0u; cnt = 0u; mine = 0u;
#pragma unroll
        for (unsigned j = 0; j < 16; ++j) { const unsigned c = xb_ld(&bar[XB_XCNT(j)]); sum += c; cnt += (c > 0u) ? 1u : 0u; mine = (j == x) ? c : mine; }
        if (sum == G) break;
        __builtin_amdgcn_s_sleep(1);
        if ((++sp & 255u) == 0u) { if (xb_ld(&bar[XB_TMO])) break; if (sp > XB_SPIN_CAP) { atomicAdd(&bar[XB_TMO], 1u); break; } }
    }
    nloc = mine > 0u ? mine : 1u; nx = cnt > 0u ? cnt : 1u;
}
__device__ __forceinline__ void xcd_barrier(const XcdBarrier& b) {
    asm volatile("s_waitcnt vmcnt(0)" ::: "memory");
    __syncthreads();
    if (threadIdx.x == 0) {
        unsigned* bar = b.bar;
        __builtin_amdgcn_s_waitcnt(0);
        unsigned nloc = b.st[0], nx = b.st[1];
        if (nloc == 0u) { xcd_barrier_complete(bar, b.x, nloc, nx); b.st[0] = nloc; b.st[1] = nx; }
        const unsigned old = xb_add(&bar[XB_XSUB(b.x)], 1u);
        const unsigned gen = old / nloc;
        if (old + 1u == (gen + 1u) * nloc) {
            __builtin_amdgcn_fence(__ATOMIC_RELEASE, "agent");
            asm volatile("s_waitcnt vmcnt(0)" ::: "memory");
            const unsigned og = xb_add(&bar[XB_TOP], 1u);
            const unsigned tg = og / nx;
            if (og + 1u == (tg + 1u) * nx) xb_add(&bar[XB_TOPGEN], 1u);
            else XB_SPIN(xb_ld(&bar[XB_TOPGEN]) == tg, bar);
            __builtin_amdgcn_fence(__ATOMIC_ACQUIRE, "agent");
            xb_add(&bar[XB_XGEN(b.x)], 1u);
            asm volatile("s_waitcnt vmcnt(0)" ::: "memory");
        } else {
            XB_SPIN(xb_ld(&bar[XB_XGEN(b.x)]) == gen, bar);
            __builtin_amdgcn_fence(__ATOMIC_ACQUIRE, "agent");
            asm volatile("s_waitcnt vmcnt(0)" ::: "memory");
        }
    }
    __syncthreads();
}

__global__ __launch_bounds__(512, 2) void k_mega(Params P) {
    extern __shared__ __attribute__((aligned(16))) unsigned char shm[];
    volatile LAS unsigned* xst = (volatile LAS unsigned*)((LAS unsigned char*)shm + LDS_BYTES - 16);
    if (threadIdx.x == 0) { xst[0] = 0u; xst[1] = 0u; }
    __syncthreads();
    const XcdBarrier xb = xcd_barrier_post((unsigned*)(P.ws + O_BAR), xst);
#define SEAM(k) xcd_barrier(xb)
    #ifdef REPEAT_PH
    _Pragma("nounroll") for (int i = 0; i < NPH + 1; ++i) { int phv = __builtin_amdgcn_readfirstlane((i <= REPEAT_PH) ? i : i - 1); asm volatile("" : "+s"(phv)); run_phase(P, phv, i == REPEAT_PH, shm); if (i < NPH) SEAM(i); }
#else
    _Pragma("nounroll") for (int ph = 0; ph < NPH; ++ph) { int phv = ph; asm volatile("" : "+s"(phv)); run_phase(P, phv, false, shm); if (ph + 1 < NPH && !(ph == 9 && gridDim.x == 256)) SEAM(ph); }
#endif
}
__global__ __launch_bounds__(512, 2) void k_phase(Params P, int ph) {
    extern __shared__ __attribute__((aligned(16))) unsigned char shm[];
    run_phase(P, ph, false, shm);
}

extern "C" void kernel_launch(void* const* d_in, const int* in_sizes, int n_in, void* d_out, int out_size, void* d_ws, size_t ws_size, hipStream_t stream) {
    static int grid = 0;
    if (grid == 0) {
        if (n_in != 21 || ws_size < WS_NEED || out_size != NTOK * DM) { fprintf(stderr, "kernel_launch: unexpected shapes (n_in %d, ws %zu need %zu, out %d)\n", n_in, ws_size, (size_t)WS_NEED, out_size); grid = -1; return; }
        int dev = 0, cus = 0, per_cu = 0;
        hipGetDevice(&dev); hipDeviceGetAttribute(&cus, hipDeviceAttributeMultiprocessorCount, dev);
        hipFuncSetAttribute((const void*)k_mega, hipFuncAttributeMaxDynamicSharedMemorySize, LDS_BYTES);
        hipFuncSetAttribute((const void*)k_phase, hipFuncAttributeMaxDynamicSharedMemorySize, LDS_BYTES);
        hipOccupancyMaxActiveBlocksPerMultiprocessor(&per_cu, (const void*)k_mega, 512, LDS_BYTES);
        if (per_cu < 1) { fprintf(stderr, "kernel_launch: occupancy query says %d blocks per CU\n", per_cu); per_cu = 1; }
        grid = cus * per_cu; if (grid > 256) grid = 256;
        (void)hipGetLastError();
    }
    if (grid < 0) return;
    Params P{};
    const float** pp = (const float**)&P;
    for (int i = 0; i < 21; ++i) pp[i] = (const float*)d_in[i];
    P.out = (float*)d_out; P.ws = (unsigned char*)d_ws;
#if ONE_LAUNCH
    if (hipMemsetAsync((unsigned char*)d_ws + O_BAR, 0, BAR_BYTES, stream) != hipSuccess) { fprintf(stderr, "kernel_launch: memset of the barrier words failed\n"); return; }
    void* args[] = {&P};
    hipError_t e = hipLaunchCooperativeKernel((const void*)k_mega, dim3(grid), dim3(512), args, LDS_BYTES, stream);
    if (e != hipSuccess) fprintf(stderr, "cooperative launch failed: %s (grid %d)\n", hipGetErrorString(e), grid);
#else
    for (int ph = 0; ph < NPH; ++ph) hipLaunchKernelGGL(k_phase, dim3(grid), dim3(512), LDS_BYTES, stream, P, ph);
#endif
}
```

```cpp
#include <hip/hip_runtime.h>
#include <hip/hip_cooperative_groups.h>
#include <cstdio>
namespace cg = cooperative_groups;

#ifndef ONE_LAUNCH
#define ONE_LAUNCH 1
#endif
#ifndef SLOW_GEMM
#define SLOW_GEMM 0
#endif
#ifndef GEMM_SP2
#define GEMM_SP2 1
#endif

#define LAS __attribute__((address_space(3)))
typedef unsigned short bf16_t;
typedef short bf16x8 __attribute__((ext_vector_type(8)));
typedef float f32x4 __attribute__((ext_vector_type(4)));
typedef unsigned u32x4 __attribute__((ext_vector_type(4)));
typedef unsigned u32x2 __attribute__((ext_vector_type(2)));

constexpr int NTOK = 32768, DM = 1024, NUP = 5632, DFF = 2816, UK = 768;
constexpr float EPS = 1e-6f;
constexpr int BM = 256, BK = 64, HALF = 128, HTB = HALF * BK * 2, STAGE_BYTES = 8 * HTB;
constexpr int LDS_BYTES = STAGE_BYTES + 18432;
constexpr int NPH = 11;

constexpr size_t O_WIN = 0;
constexpr size_t O_WGLU = O_WIN + (size_t)1536 * 1024 * 2;
constexpr size_t O_WOUT = O_WGLU + (size_t)512 * 512 * 2;
constexpr size_t O_WUP = O_WOUT + (size_t)1024 * 1024 * 2;
constexpr size_t O_WDN = O_WUP + (size_t)5632 * 1024 * 2;
constexpr size_t O_AL = O_WDN + (size_t)1024 * 2816 * 2;
constexpr size_t O_WST = O_AL + (size_t)2048 * 4096 * 2;
constexpr size_t O_WY = O_WST + (size_t)32 * 256 * 512 * 2;
constexpr size_t O_KTAB = O_WY + (size_t)32 * 512 * 768 * 2;
constexpr size_t O_SS1 = O_KTAB + (size_t)32 * 2 * 32 * 256 * 4;
constexpr size_t O_SS2 = O_SS1 + (size_t)32768 * 16 * 4;
constexpr size_t O_EB = O_SS2 + (size_t)32768 * 16 * 4;
constexpr size_t O_XN = O_EB + (size_t)128 * 4 * 5632 * 4;
constexpr size_t O_CAT = O_XN + (size_t)32768 * 1024 * 2;
constexpr size_t O_U = O_CAT + (size_t)32768 * 1024 * 2;
constexpr size_t O_PQT = O_U + (size_t)32 * 1024 * 768 * 2;
constexpr size_t O_SLOC = O_PQT + (size_t)8192 * 4096 * 2;
constexpr size_t O_Z = O_SLOC + (size_t)32 * 1024 * 256 * 4;
constexpr size_t O_ACT = O_U;
constexpr size_t O_BAR = O_Z + (size_t)32768 * 512 * 2;
constexpr size_t BAR_BYTES = 65536;
constexpr size_t WS_NEED = O_BAR + BAR_BYTES;

struct Params {
    const float *x, *g_mix, *w_in, *lam_re, *lam_im, *log_dt, *b_re, *b_im, *c_re, *c_im, *ssm_d, *w_glu, *b_glu, *w_fourier, *w_out, *g_ffn, *w_up, *conv_w, *conv_b, *w_down, *g_final;
    float* out; unsigned char* ws;
};

__device__ __forceinline__ unsigned cvt_pk_bf16(float lo, float hi) { unsigned r; asm volatile("v_cvt_pk_bf16_f32 %0, %1, %2" : "=v"(r) : "v"(lo), "v"(hi)); return r; }
__device__ __forceinline__ bf16_t f2bf(float f) { return (bf16_t)(cvt_pk_bf16(f, 0.f) & 0xffffu); }
__device__ __forceinline__ float bflo(unsigned w) { return __uint_as_float(w << 16); }
__device__ __forceinline__ float bfhi(unsigned w) { return __uint_as_float(w & 0xffff0000u); }
__device__ __forceinline__ float gelu_t(float x) {
    const float u = x * (1.0f + 0.044715f * x * x);
    const float e = __builtin_amdgcn_exp2f(-2.0f * 0.7978845608f * 1.4426950409f * u);
    return x * __builtin_amdgcn_rcpf(1.0f + e);
}
typedef float f32x2 __attribute__((ext_vector_type(2)));
template <int CTRL> __device__ __forceinline__ float dpp_rot(float src) { return __int_as_float(__builtin_amdgcn_mov_dpp(__float_as_int(src), CTRL, 0xf, 0xf, false)); }
__device__ __forceinline__ f32x2 gelu_t2(f32x2 x) {
    const f32x2 u = x * (x * x * 0.044715f + 1.0f), a = u * (-2.0f * 0.7978845608f * 1.4426950409f);
    f32x2 e; e[0] = __builtin_amdgcn_exp2f(a[0]); e[1] = __builtin_amdgcn_exp2f(a[1]);
    const f32x2 d = e + 1.0f; f32x2 r; r[0] = __builtin_amdgcn_rcpf(d[0]); r[1] = __builtin_amdgcn_rcpf(d[1]);
    return x * r;
}
template <int CTRL> __device__ __forceinline__ float dpp_mov(float src) { return __int_as_float(__builtin_amdgcn_update_dpp(0, __float_as_int(src), CTRL, 0xf, 0xf, false)); }
template <int CTRL> __device__ __forceinline__ float dpp_upd(float old, float src) { return __int_as_float(__builtin_amdgcn_update_dpp(__float_as_int(old), __float_as_int(src), CTRL, 0xf, 0xf, false)); }
__device__ __forceinline__ float sigmoid_f(float g) { return __builtin_amdgcn_rcpf(1.0f + __builtin_amdgcn_exp2f(-1.4426950409f * g)); }

__device__ __forceinline__ int lds_byte(int r, int c) { const int st = (r >> 4) * 2 + (c >> 5), rr = r & 15, cc = c & 31, ob = rr * 64 + cc * 2; return st * 1024 + (ob ^ (((ob >> 9) & 1) << 5)); }
__device__ __forceinline__ void stage_rc(int b, int& R, int& C) { const int st = b / 1024, sb = b % 1024, swz = sb ^ (((sb >> 9) & 1) << 5); R = (st >> 1) * 16 + swz / 64; C = (st & 1) * 32 + (swz % 64) / 2; }
__device__ __forceinline__ int perm32(int rho) { const int n = rho >> 4, i = rho & 15; return 8 * (i >> 2) + 4 * n + (i & 3); }

struct Unit { const char* A; const char* B; int pm, pn, aux; };
struct Order {
    const char* A; const char* B; int nM, nN, nBatch; size_t bA, bB, sA, sB; int G, c;
    __device__ __forceinline__ bool next(int i, Unit& u) const {
        const int per = nM * nN; long L = (long)i * G + c;
        if (nBatch > 1 && per <= G / 8 && (G / 8) % per == 0) {
            const int xcd = c & 7, slot = c >> 3, bpx = (G / 8) / per, b = i * 8 * bpx + (slot / per) * 8 + xcd;
            if (b >= nBatch) return false;
            L = (long)b * per + slot % per;
        }
        if (L >= (long)per * nBatch) return false;
        const int bt = (int)(L / per); int w = (int)(L % per); int pm, pn;
        if (nBatch == 1) {
            const int nwg = per; int wgid = w; { const int q = nwg / 8, r = nwg % 8, xcd = wgid % 8, off = wgid / 8; wgid = (xcd < r ? xcd * (q + 1) : r * (q + 1) + (xcd - r) * q) + off; }
            const int nig = 8 * nN, gid = wgid / nig, fm = gid * 8, gsz = (nM - fm) < 8 ? (nM - fm) : 8;
            pm = fm + ((wgid % nig) % gsz); pn = (wgid % nig) / gsz;
        } else { pm = w / nN; pn = w % nN; }
        u.pm = pm; u.pn = pn; u.aux = bt; u.A = A + (size_t)bt * bA + (size_t)pm * sA; u.B = B + (size_t)bt * bB + (size_t)pn * sB; return true;
    }
};

template <class Epi>
__device__ __forceinline__ void gemm_phase(LAS unsigned char* lds, const int K, const int lda, const int ldb, const Order& S, const Epi& E) {
    int tid_ = threadIdx.x; asm volatile("" : "+v"(tid_));
    const int tid = tid_, wid = __builtin_amdgcn_readfirstlane(tid >> 6), lane = tid & 63, wr = wid >> 2, wc = wid & 3, fr = lane & 15, fq = lane >> 4;
    Unit cur, nxt; int ui = 0;
    if (!S.next(0, cur)) return;
    f32x4 acc[2][2][4][2];
#if SLOW_GEMM
    for (;;) {
#pragma unroll
        for (int ai = 0; ai < 2; ++ai)
#pragma unroll
            for (int bj = 0; bj < 2; ++bj)
#pragma unroll
                for (int m = 0; m < 4; ++m)
#pragma unroll
                    for (int n = 0; n < 2; ++n)
#pragma unroll
                        for (int e = 0; e < 4; ++e) {
                            const int row = 128 * ai + 64 * wr + 16 * m + fr, col = Epi::PERM ? (128 * bj + 32 * wc + 8 * fq + 4 * n + e) : (128 * bj + 32 * wc + 16 * n + 4 * fq + e);
                            const u32x4* ap = (const u32x4*)(cur.A + (size_t)row * lda * 2); const u32x4* bp = (const u32x4*)(cur.B + (size_t)col * ldb * 2);
                            float s = 0.f;
                            for (int k = 0; k < K / 8; ++k) { const u32x4 a = ap[k], b = bp[k];
                                s += bflo(a.x) * bflo(b.x) + bfhi(a.x) * bfhi(b.x) + bflo(a.y) * bflo(b.y) + bfhi(a.y) * bfhi(b.y) + bflo(a.z) * bflo(b.z) + bfhi(a.z) * bfhi(b.z) + bflo(a.w) * bflo(b.w) + bfhi(a.w) * bfhi(b.w); }
                            acc[ai][bj][m][n][e] = s;
                        }
        E(acc, cur, wr, wc, fr, fq);
        if (!S.next(++ui, nxt)) break;
        cur = nxt;
    }
    if (wr == 0) __builtin_amdgcn_s_barrier();
    __builtin_amdgcn_s_barrier();
#else
    int nt = K / BK; asm volatile("" : "+s"(nt));
    unsigned voffA[2], voffB[2];
#pragma unroll
    for (int i = 0; i < 2; ++i) { int R, C; stage_rc(tid * 16 + i * 8192, R, C); const int Rb = Epi::PERM ? ((R & ~31) + perm32(R & 31)) : R;
        voffA[i] = (unsigned)(R * lda + C) * 2u; voffB[i] = (unsigned)(Rb * ldb + C) * 2u; }
    const size_t kstep = (size_t)(BK * 2);
    const size_t hA = (size_t)HALF * lda * 2, hB = (size_t)HALF * ldb * 2;
    const unsigned ldsw = (unsigned)wid * 1024u;
    const int aoff = lds_byte(wr * 64 + fr, fq * 8), boff = lds_byte(wc * 32 + fr, fq * 8);
#define PG8_SA(b, h) (((b) * 2 + (h)) * HTB)
#define PG8_SB(b, h) ((4 + (b) * 2 + (h)) * HTB)
#define PG8_STAGE(bufoff, gbase, voff) do { _Pragma("unroll") for (int _i = 0; _i < 2; ++_i) \
        __builtin_amdgcn_global_load_lds((const unsigned*)((const char*)(gbase) + (voff)[_i]), (LAS unsigned*)(lds + (bufoff) + ldsw + _i * 8192), 16, 0, 0); } while (0)
#define PG8_LDA(dst, b, h) do { _Pragma("unroll") for (int m = 0; m < 4; ++m) _Pragma("unroll") for (int k = 0; k < 2; ++k) dst[m][k] = *(const LAS bf16x8*)(lds + PG8_SA(b, h) + aoff + m * 2048 + k * 1024); } while (0)
#define PG8_LDB(dst, b, h) do { _Pragma("unroll") for (int n = 0; n < 2; ++n) _Pragma("unroll") for (int k = 0; k < 2; ++k) dst[n][k] = *(const LAS bf16x8*)(lds + PG8_SB(b, h) + boff + n * 2048 + k * 1024); } while (0)
#define PG8_MMA(ai, bj, At, Bt) do { __builtin_amdgcn_s_setprio(1); _Pragma("unroll") for (int m = 0; m < 4; ++m) _Pragma("unroll") for (int n = 0; n < 2; ++n) _Pragma("unroll") for (int k = 0; k < 2; ++k) \
        acc[ai][bj][m][n] = __builtin_amdgcn_mfma_f32_16x16x32_bf16(Bt[n][k], At[m][k], acc[ai][bj][m][n], 0, 0, 0); __builtin_amdgcn_s_setprio(0); } while (0)
#define PG8_WAIT_V(n) asm volatile("s_waitcnt vmcnt(" #n ")" ::: "memory")
#define PG8_WAIT_L(n) asm volatile("s_waitcnt lgkmcnt(" #n ")" ::: "memory")
#define PG8_BAR __builtin_amdgcn_s_barrier()
#define PG8_SCHED __builtin_amdgcn_sched_barrier(0)
#pragma unroll
    for (int a = 0; a < 2; ++a)
#pragma unroll
        for (int b = 0; b < 2; ++b)
#pragma unroll
            for (int m = 0; m < 4; ++m)
#pragma unroll
                for (int n = 0; n < 2; ++n) acc[a][b][m][n] = (f32x4){0.f, 0.f, 0.f, 0.f};
    bf16x8 At[4][2], B0[2][2], B1[2][2];
    const char* cA = cur.A; const char* cB = cur.B;
#if GEMM_SP2
    PG8_STAGE(PG8_SB(0, 0), cB, voffB); PG8_STAGE(PG8_SB(0, 1), cB + hB, voffB); PG8_STAGE(PG8_SA(0, 0), cA, voffA); PG8_STAGE(PG8_SA(0, 1), cA + hA, voffA);
    if (wr == 1) PG8_BAR;
    PG8_WAIT_V(2); PG8_BAR;
    PG8_STAGE(PG8_SB(1, 0), cB + kstep, voffB); PG8_STAGE(PG8_SA(1, 0), cA + kstep, voffA); PG8_STAGE(PG8_SB(1, 1), cB + hB + kstep, voffB);
    PG8_WAIT_V(6); PG8_BAR;
#else
    PG8_STAGE(PG8_SB(0, 0), cB, voffB); PG8_STAGE(PG8_SA(0, 0), cA, voffA); PG8_STAGE(PG8_SB(0, 1), cB + hB, voffB); PG8_STAGE(PG8_SA(0, 1), cA + hA, voffA);
    if (wr == 1) PG8_BAR;
    PG8_WAIT_V(4); PG8_BAR;
    PG8_STAGE(PG8_SB(1, 0), cB + kstep, voffB); PG8_STAGE(PG8_SA(1, 0), cA + kstep, voffA); PG8_STAGE(PG8_SB(1, 1), cB + hB + kstep, voffB);
    PG8_WAIT_V(6); PG8_BAR;
#endif
    for (;;) {
        const bool has_next = S.next(ui + 1, nxt);
        const char* nA = has_next ? nxt.A : cA; const char* nB = has_next ? nxt.B : cB;
        _Pragma("nounroll") for (int t = 0; t < nt; t += 2) {
            const bool last = (t == nt - 2);
            const char* a1 = cA + (size_t)(t + 1) * kstep;
            const char* a2 = last ? nA : cA + (size_t)(t + 2) * kstep; const char* b2 = last ? nB : cB + (size_t)(t + 2) * kstep;
            const char* a3 = a2 + kstep; const char* b3 = b2 + kstep;
#if GEMM_SP2
            PG8_LDB(B0, 0, 0); PG8_LDB(B1, 0, 1); PG8_SCHED; PG8_LDA(At, 0, 0); PG8_STAGE(PG8_SA(1, 1), a1 + hA, voffA);
            if (t != 0) PG8_WAIT_V(8);
            PG8_WAIT_L(0); PG8_BAR;
            if constexpr (Epi::HAS_PRE) { if (t == 0) E.pre(cur, wid, lane); }
            PG8_MMA(0, 0, At, B0); PG8_MMA(0, 1, At, B1); PG8_BAR; PG8_SCHED;
            PG8_LDA(At, 0, 1); PG8_STAGE(PG8_SB(0, 0), b2, voffB); PG8_STAGE(PG8_SB(0, 1), b2 + hB, voffB); PG8_STAGE(PG8_SA(0, 0), a2, voffA);
            PG8_WAIT_V(8); PG8_WAIT_L(0); PG8_BAR; PG8_MMA(1, 0, At, B0); PG8_MMA(1, 1, At, B1); PG8_BAR; PG8_SCHED;
            PG8_LDB(B0, 1, 0); PG8_LDB(B1, 1, 1); PG8_SCHED; PG8_LDA(At, 1, 0); PG8_STAGE(PG8_SA(0, 1), a2 + hA, voffA);
            PG8_WAIT_V(8); PG8_WAIT_L(0); PG8_BAR; PG8_MMA(0, 0, At, B0); PG8_MMA(0, 1, At, B1); PG8_BAR; PG8_SCHED;
            PG8_LDA(At, 1, 1); PG8_STAGE(PG8_SB(1, 0), b3, voffB); PG8_STAGE(PG8_SB(1, 1), b3 + hB, voffB); PG8_STAGE(PG8_SA(1, 0), a3, voffA);
            if (last) PG8_WAIT_V(6); else PG8_WAIT_V(8);
            PG8_WAIT_L(0); PG8_BAR; PG8_MMA(1, 0, At, B0); PG8_MMA(1, 1, At, B1); PG8_BAR; PG8_SCHED;
#else
            PG8_LDB(B0, 0, 0); PG8_SCHED; PG8_LDA(At, 0, 0); PG8_STAGE(PG8_SA(1, 1), a1 + hA, voffA);
            PG8_WAIT_L(8); PG8_BAR;
            if constexpr (Epi::HAS_PRE) { if (t == 0) E.pre(cur, wid, lane); }
            PG8_WAIT_L(0); PG8_MMA(0, 0, At, B0); PG8_BAR; PG8_SCHED;
            PG8_LDB(B1, 0, 1); PG8_STAGE(PG8_SB(0, 0), b2, voffB);
            PG8_BAR; PG8_WAIT_L(0); PG8_MMA(0, 1, At, B1); PG8_BAR;
            PG8_LDA(At, 0, 1); PG8_STAGE(PG8_SA(0, 0), a2, voffA);
            PG8_BAR; PG8_WAIT_L(0); PG8_MMA(1, 0, At, B0); PG8_BAR; PG8_SCHED;
            PG8_STAGE(PG8_SB(0, 1), b2 + hB, voffB);
            PG8_WAIT_V(6); PG8_BAR; PG8_MMA(1, 1, At, B1); PG8_BAR;
            PG8_LDB(B0, 1, 0); PG8_SCHED; PG8_LDA(At, 1, 0); PG8_STAGE(PG8_SA(0, 1), a2 + hA, voffA);
            PG8_WAIT_L(8); PG8_BAR; PG8_WAIT_L(0); PG8_MMA(0, 0, At, B0); PG8_BAR; PG8_SCHED;
            PG8_LDB(B1, 1, 1); PG8_STAGE(PG8_SB(1, 0), b3, voffB);
            PG8_BAR; PG8_WAIT_L(0); PG8_MMA(0, 1, At, B1); PG8_BAR;
            PG8_LDA(At, 1, 1); PG8_STAGE(PG8_SA(1, 0), a3, voffA);
            PG8_BAR; PG8_WAIT_L(0); PG8_MMA(1, 0, At, B0); PG8_BAR; PG8_SCHED;
            PG8_STAGE(PG8_SB(1, 1), b3 + hB, voffB);
            PG8_WAIT_V(6); PG8_BAR; PG8_MMA(1, 1, At, B1); PG8_BAR;
#endif
        }
        if (wr == 0) PG8_BAR;
        E(acc, cur, wr, wc, fr, fq);
        if (wr == 1) PG8_BAR;
        if (!has_next) break;
#pragma unroll
        for (int a = 0; a < 2; ++a)
#pragma unroll
            for (int b = 0; b < 2; ++b)
#pragma unroll
                for (int m = 0; m < 4; ++m)
#pragma unroll
                    for (int n = 0; n < 2; ++n) acc[a][b][m][n] = (f32x4){0.f, 0.f, 0.f, 0.f};
        cur = nxt; cA = nA; cB = nB; ++ui;
    }
    PG8_WAIT_V(0);
    if (wr == 0) PG8_BAR;
    PG8_BAR;
#undef PG8_SA
#undef PG8_SB
#undef PG8_STAGE
#undef PG8_LDA
#undef PG8_LDB
#undef PG8_MMA
#undef PG8_WAIT_V
#undef PG8_WAIT_L
#undef PG8_BAR
#undef PG8_SCHED
#endif
}

typedef f32x4 Acc[2][2][4][2];
__device__ __forceinline__ u32x4 pack8(const f32x4 a, const f32x4 b) { u32x4 w; w.x = cvt_pk_bf16(a[0], a[1]); w.y = cvt_pk_bf16(a[2], a[3]); w.z = cvt_pk_bf16(b[0], b[1]); w.w = cvt_pk_bf16(b[2], b[3]); return w; }

struct EpiIn {
    static constexpr bool PERM = true, HAS_PRE = false;
    bf16_t* U; bf16_t* PQT;
    __device__ __forceinline__ void operator()(const Acc& acc, const Unit& u, int wr, int wc, int fr, int fq) const {
#pragma unroll
        for (int ai = 0; ai < 2; ++ai)
#pragma unroll
            for (int m = 0; m < 4; ++m) {
                const int tok = u.pm * 256 + 128 * ai + 64 * wr + 16 * m + fr;
#pragma unroll
                for (int bj = 0; bj < 2; ++bj) {
                    if (u.pn < 2) {
                        const int c = 256 * u.pn + 128 * bj + 32 * wc + 8 * fq, g = c >> 4, h0 = c & 15;
                        *(u32x4*)(U + ((size_t)(g * 1024 + (tok >> 5))) * UK + (tok & 31) * 16 + h0) = pack8(acc[ai][bj][m][0], acc[ai][bj][m][1]);
                    } else {
                        const int b = tok >> 11, l = tok & 2047;
#pragma unroll
                        for (int n = 0; n < 2; ++n)
#pragma unroll
                            for (int e = 0; e < 4; ++e) {
                                const int cc = 256 * (u.pn - 2) + 128 * bj + 32 * wc + 8 * fq + 4 * n + e, h = cc >> 7, r = cc & 127, bh = b * 4 + h;
                                const size_t row = (r < 64) ? (size_t)(bh * 64 + r) : (r == 64) ? (size_t)(4096 + bh) : (size_t)(4352 + bh * 64 + (r - 64));
                                PQT[row * 2048 + l] = f2bf(acc[ai][bj][m][n][e]);
                            }
                    }
                }
            }
    }
};
struct EpiSloc {
    static constexpr bool PERM = false, HAS_PRE = false;
    float* S;
    __device__ __forceinline__ void operator()(const Acc& acc, const Unit& u, int wr, int wc, int fr, int fq) const {
#pragma unroll
        for (int ai = 0; ai < 2; ++ai)
#pragma unroll
            for (int m = 0; m < 4; ++m) {
                float* rp = S + ((size_t)(u.aux * 1024 + u.pm * 256 + 128 * ai + 64 * wr + 16 * m + fr)) * 256 + 32 * wc + 4 * fq;
#pragma unroll
                for (int bj = 0; bj < 2; ++bj)
#pragma unroll
                    for (int n = 0; n < 2; ++n) *(f32x4*)(rp + 128 * bj + 16 * n) = acc[ai][bj][m][n];
            }
    }
};
struct EpiDft {
    static constexpr bool PERM = true, HAS_PRE = false;
    bf16_t* EO;
    __device__ __forceinline__ void operator()(const Acc& acc, const Unit& u, int wr, int wc, int fr, int fq) const {
#pragma unroll
        for (int ai = 0; ai < 2; ++ai)
#pragma unroll
            for (int m = 0; m < 4; ++m) {
                const int k = u.pm * 256 + 128 * ai + 64 * wr + 16 * m + fr;
#pragma unroll
                for (int bj = 0; bj < 2; ++bj) {
                    const int n = 256 * u.pn + 128 * bj + 32 * wc + 8 * fq;
                    *(u32x4*)(EO + ((size_t)(u.aux * 1024 + k)) * 4352 + n) = pack8(acc[ai][bj][m][0], acc[ai][bj][m][1]);
                }
            }
    }
};
struct EpiY {
    static constexpr bool PERM = true, HAS_PRE = false;
    bf16_t* Z;
    __device__ __forceinline__ void operator()(const Acc& acc, const Unit& u, int wr, int wc, int fr, int fq) const {
#pragma unroll
        for (int ai = 0; ai < 2; ++ai)
#pragma unroll
            for (int m = 0; m < 4; ++m) {
                const int R = u.pm * 256 + 128 * ai + 64 * wr + 16 * m + fr;
#pragma unroll
                for (int bj = 0; bj < 2; ++bj) {
                    const int c = 256 * u.pn + 128 * bj + 32 * wc + 8 * fq, t = c >> 4, h0 = c & 15;
                    f32x4 a = acc[ai][bj][m][0], b = acc[ai][bj][m][1];
                    { const f32x2 g0 = gelu_t2((f32x2){a[0], a[1]}), g1 = gelu_t2((f32x2){a[2], a[3]}), g2 = gelu_t2((f32x2){b[0], b[1]}), g3 = gelu_t2((f32x2){b[2], b[3]});
                      a = (f32x4){g0[0], g0[1], g1[0], g1[1]}; b = (f32x4){g2[0], g2[1], g3[0], g3[1]}; }
                    *(u32x4*)(Z + ((size_t)(R * 32 + t)) * 512 + u.aux * 16 + h0) = pack8(a, b);
                }
            }
    }
};
struct EpiGlu {
    static constexpr bool PERM = true, HAS_PRE = false;
    const bf16_t* Z; const float* bias; bf16_t* cat;
    __device__ __forceinline__ void operator()(const Acc& acc, const Unit& u, int wr, int wc, int fr, int fq) const {
        const int c0 = 256 * u.pn + 32 * wc + 8 * fq, tok0 = u.pm * 256 + 64 * wr + fr;
        f32x4 bv[2][2];
#pragma unroll
        for (int bj = 0; bj < 2; ++bj) { bv[bj][0] = *(const f32x4*)(bias + c0 + 128 * bj); bv[bj][1] = *(const f32x4*)(bias + c0 + 128 * bj + 4); }
#pragma unroll
        for (int ai = 0; ai < 2; ++ai) {
            u32x4 zz[4][2];
#pragma unroll
            for (int m = 0; m < 4; ++m)
#pragma unroll
                for (int bj = 0; bj < 2; ++bj) zz[m][bj] = *(const u32x4*)(Z + (size_t)(tok0 + 128 * ai + 16 * m) * 512 + c0 + 128 * bj);
#pragma unroll
            for (int m = 0; m < 4; ++m)
#pragma unroll
                for (int bj = 0; bj < 2; ++bj) {
                    const u32x4 z = zz[m][bj];
                    f32x4 a = acc[ai][bj][m][0] + bv[bj][0], b = acc[ai][bj][m][1] + bv[bj][1];
                    a[0] = bflo(z.x) * sigmoid_f(a[0]); a[1] = bfhi(z.x) * sigmoid_f(a[1]); a[2] = bflo(z.y) * sigmoid_f(a[2]); a[3] = bfhi(z.y) * sigmoid_f(a[3]);
                    b[0] = bflo(z.z) * sigmoid_f(b[0]); b[1] = bfhi(z.z) * sigmoid_f(b[1]); b[2] = bflo(z.w) * sigmoid_f(b[2]); b[3] = bfhi(z.w) * sigmoid_f(b[3]);
                    *(u32x4*)(cat + (size_t)(tok0 + 128 * ai + 16 * m) * 1024 + c0 + 128 * bj) = pack8(a, b);
                }
        }
    }
};
template <bool BASE_BF> struct EpiRes {
    static constexpr bool PERM = true, HAS_PRE = false;
    const void* base; bf16_t* H; float* ss; LAS float* RED;
    __device__ __forceinline__ void operator()(const Acc& acc, const Unit& u, int wr, int wc, int fr, int fq) const {
        const int c0 = 256 * u.pn + 32 * wc + 8 * fq, tok0 = u.pm * 256 + 64 * wr + fr;
        float sarr[8];
#pragma unroll
        for (int ai = 0; ai < 2; ++ai) {
            f32x4 bv[4][2][2]; u32x4 bz[4][2];
#pragma unroll
            for (int m = 0; m < 4; ++m)
#pragma unroll
                for (int bj = 0; bj < 2; ++bj) { const size_t o = (size_t)(tok0 + 128 * ai + 16 * m) * 1024 + c0 + 128 * bj;
                    if (BASE_BF) bz[m][bj] = *(const u32x4*)((const bf16_t*)base + o);
                    else { bv[m][bj][0] = *(const f32x4*)((const float*)base + o); bv[m][bj][1] = *(const f32x4*)((const float*)base + o + 4); } }
#pragma unroll
            for (int m = 0; m < 4; ++m) {
                float s = 0.f;
#pragma unroll
                for (int bj = 0; bj < 2; ++bj) {
                    const size_t o = (size_t)(tok0 + 128 * ai + 16 * m) * 1024 + c0 + 128 * bj;
                    f32x4 a, b;
                    if (BASE_BF) { const u32x4 z = bz[m][bj]; a = acc[ai][bj][m][0] + (f32x4){bflo(z.x), bfhi(z.x), bflo(z.y), bfhi(z.y)}; b = acc[ai][bj][m][1] + (f32x4){bflo(z.z), bfhi(z.z), bflo(z.w), bfhi(z.w)}; }
                    else { a = acc[ai][bj][m][0] + bv[m][bj][0]; b = acc[ai][bj][m][1] + bv[m][bj][1]; }
                    *(u32x4*)(H + o) = pack8(a, b);
                    s += (a[0] * a[0] + a[1] * a[1]) + (a[2] * a[2] + a[3] * a[3]) + (b[0] * b[0] + b[1] * b[1]) + (b[2] * b[2] + b[3] * b[3]);
                }
                s += __shfl_xor(s, 16); s += __shfl_xor(s, 32);
                sarr[ai * 4 + m] = s;
            }
        }
        if (fq == 0) {
#pragma unroll
            for (int i = 0; i < 8; ++i) RED[(64 * wr + fr + 128 * (i >> 2) + 16 * (i & 3)) * 4 + wc] = sarr[i];
        }
        asm volatile("s_waitcnt lgkmcnt(0)" ::: "memory"); __builtin_amdgcn_s_barrier(); asm volatile("" ::: "memory");
        const int tid = (wr * 4 + wc) * 64 + fq * 16 + fr;
        if (tid < 256) { const f32x4 r = *(const LAS f32x4*)(RED + tid * 4); ss[(size_t)(u.pm * 256 + tid) * 4 + u.pn] = (r[0] + r[1]) + (r[2] + r[3]); }
    }
};
struct EpiFinal {
    static constexpr bool PERM = false, HAS_PRE = false;
    const bf16_t* base; float* out; const float* gfin; float* xs; unsigned* cnt; LAS float* RED;
    __device__ __forceinline__ void operator()(const Acc& acc_in, const Unit& u, int wr, int wc, int fr, int fq) const {
        Acc& acc = const_cast<Acc&>(acc_in);
        const int c0 = 256 * u.pn + 32 * wc + 4 * fq, tok0 = u.pm * 256 + 64 * wr + fr, tid = (wr * 4 + wc) * 64 + fq * 16 + fr;
        float sarr[8];
#pragma unroll
        for (int ai = 0; ai < 2; ++ai) {
            u32x2 bz[4][2][2];
#pragma unroll
            for (int m = 0; m < 4; ++m)
#pragma unroll
                for (int bj = 0; bj < 2; ++bj)
#pragma unroll
                    for (int n = 0; n < 2; ++n) bz[m][bj][n] = *(const u32x2*)(base + (size_t)(tok0 + 128 * ai + 16 * m) * 1024 + c0 + 128 * bj + 16 * n);
#pragma unroll
            for (int m = 0; m < 4; ++m) {
                float s = 0.f;
#pragma unroll
                for (int bj = 0; bj < 2; ++bj) {
                    const u32x2 z0 = bz[m][bj][0], z1 = bz[m][bj][1];
                    const f32x4 a = acc[ai][bj][m][0] + (f32x4){bflo(z0.x), bfhi(z0.x), bflo(z0.y), bfhi(z0.y)}, b = acc[ai][bj][m][1] + (f32x4){bflo(z1.x), bfhi(z1.x), bflo(z1.y), bfhi(z1.y)};
                    acc[ai][bj][m][0] = a; acc[ai][bj][m][1] = b;
                    s += (a[0] * a[0] + a[1] * a[1]) + (a[2] * a[2] + a[3] * a[3]) + (b[0] * b[0] + b[1] * b[1]) + (b[2] * b[2] + b[3] * b[3]);
                }
                s += __shfl_xor(s, 16); s += __shfl_xor(s, 32);
                sarr[ai * 4 + m] = s;
            }
        }
        if (fq == 0) {
#pragma unroll
            for (int i = 0; i < 8; ++i) RED[(64 * wr + fr + 128 * (i >> 2) + 16 * (i & 3)) * 4 + wc] = sarr[i];
        }
        asm volatile("s_waitcnt lgkmcnt(0)" ::: "memory"); __builtin_amdgcn_s_barrier(); asm volatile("" ::: "memory");
        if (tid < 256) { const f32x4 r = *(const LAS f32x4*)(RED + tid * 4); xs[(size_t)(u.pm * 256 + tid) * 4 + u.pn] = (r[0] + r[1]) + (r[2] + r[3]); }
        asm volatile("s_waitcnt vmcnt(0)" ::: "memory"); __builtin_amdgcn_s_barrier(); asm volatile("" ::: "memory");
        if (tid == 0) {
            unsigned* c = cnt + (size_t)u.pm * 64;
            __builtin_amdgcn_fence(__ATOMIC_RELEASE, "agent");
            asm volatile("s_waitcnt vmcnt(0)" ::: "memory");
            (void)__hip_atomic_fetch_add(c, 1u, __ATOMIC_RELAXED, __HIP_MEMORY_SCOPE_AGENT);
            unsigned sp = 0u;
            while (__hip_atomic_load(c, __ATOMIC_RELAXED, __HIP_MEMORY_SCOPE_AGENT) < 4u) { __builtin_amdgcn_s_sleep(1); if (++sp > (1u << 22)) break; }
            __builtin_amdgcn_fence(__ATOMIC_ACQUIRE, "agent");
            asm volatile("s_waitcnt vmcnt(0)" ::: "memory");
        }
        __builtin_amdgcn_s_barrier(); asm volatile("" ::: "memory");
        if (tid < 256) { const f32x4 p = *(const f32x4*)(xs + (size_t)(u.pm * 256 + tid) * 4); RED[1024 + tid] = rsqrtf(((p[0] + p[1]) + (p[2] + p[3])) * (1.0f / DM) + EPS); }
        asm volatile("s_waitcnt lgkmcnt(0)" ::: "memory"); __builtin_amdgcn_s_barrier(); asm volatile("" ::: "memory");
        f32x4 gv[2][2];
#pragma unroll
        for (int bj = 0; bj < 2; ++bj) { gv[bj][0] = *(const f32x4*)(gfin + c0 + 128 * bj); gv[bj][1] = *(const f32x4*)(gfin + c0 + 128 * bj + 16); }
#pragma unroll
        for (int ai = 0; ai < 2; ++ai)
#pragma unroll
            for (int m = 0; m < 4; ++m) {
                const float rs = RED[1024 + 64 * wr + fr + 128 * ai + 16 * m];
#pragma unroll
                for (int bj = 0; bj < 2; ++bj) { float* op = out + (size_t)(tok0 + 128 * ai + 16 * m) * 1024 + c0 + 128 * bj;
                    *(f32x4*)op = acc[ai][bj][m][0] * rs * gv[bj][0]; *(f32x4*)(op + 16) = acc[ai][bj][m][1] * rs * gv[bj][1]; }
            }
    }
};
struct EpiUp {
    static constexpr bool PERM = true, HAS_PRE = true;
    __device__ __forceinline__ void pre(const Unit& u, int wid, int lane) const {
        if (wid < 4) {
            const int t = wid * 64 + lane, k = t >> 6, c = (t & 63) * 4, col = (c >> 7) * DFF + u.pn * 128 + (c & 127);
            const float* src = (k < 3) ? cw + (size_t)k * NUP + col : cb + col;
            __builtin_amdgcn_global_load_lds((const unsigned*)src, (LAS unsigned*)(X + 2048 + wid * 256), 16, 0, 0);
            __builtin_amdgcn_global_load_lds((const unsigned*)(ss + (size_t)(u.pm * 256 + t) * 4), (LAS unsigned*)(X + 3072 + wid * 256), 16, 0, 0);
        }
    }
    const float* ss; const float* cw; const float* cb; bf16_t* act; float* EB; LAS float* X;
    __device__ __forceinline__ void operator()(const Acc& acc_in, const Unit& u, int wr, int wc, int fr_, int fq_) const {
        Acc& acc = const_cast<Acc&>(acc_in);
        int lane = threadIdx.x & 63; asm volatile("" : "+v"(lane));
        const int fr = lane & 15, fq = lane >> 4, tid = (wr * 4 + wc) * 64 + lane;
        const int cl = 32 * wc + 8 * fq;
        LAS float* CST = X + 2048; LAS float* RSP = X + 3072; LAS float* RS = X + 4096;
        if (tid < 256) { const f32x4 r = *(const LAS f32x4*)(RSP + tid * 4); RS[tid] = rsqrtf(((r[0] + r[1]) + (r[2] + r[3])) * (1.0f / DM) + EPS); }
#pragma unroll
        for (int ai = 0; ai < 2; ++ai) {
            const int q = 2 * ai + wr;
#pragma unroll
            for (int bj = 0; bj < 2; ++bj)
#pragma unroll
                for (int n = 0; n < 2; ++n) {
                    const bool f0 = (fr == 0), f15 = (fr == 15);
                    f32x4 lo = acc[ai][bj][0][n], hi = acc[ai][bj][3][n], sv;
#pragma unroll
                    for (int e = 0; e < 4; ++e) sv[e] = f0 ? lo[e] : hi[e];
                    if (f0 || f15) *(LAS f32x4*)(X + (q * 2 + (f0 ? 0 : 1)) * 256 + 128 * bj + cl + 4 * n) = sv;
                }
        }
        asm volatile("s_waitcnt lgkmcnt(0)" ::: "memory");
        __builtin_amdgcn_s_barrier();
        asm volatile("" ::: "memory");
#pragma unroll
        for (int ai = 0; ai < 2; ++ai) {
            const int q = 2 * ai + wr;
#pragma unroll
            for (int m = 0; m < 4; ++m) {
                const float rs = RS[128 * ai + 64 * wr + 16 * m + fr];
#pragma unroll
                for (int bj = 0; bj < 2; ++bj)
#pragma unroll
                    for (int n = 0; n < 2; ++n) acc[ai][bj][m][n] = acc[ai][bj][m][n] * rs;
            }
#pragma unroll
            for (int bj = 0; bj < 2; ++bj)
#pragma unroll
                for (int n = 0; n < 2; ++n) {
                    const bool e0 = (q == 0 && fr < 2), e3 = (q == 3 && fr >= 14);
                    f32x4 lo = acc[ai][bj][0][n], hi = acc[ai][bj][3][n], ev;
#pragma unroll
                    for (int e = 0; e < 4; ++e) ev[e] = e0 ? lo[e] : hi[e];
                    const size_t ec = (size_t)bj * DFF + u.pn * 128 + cl + 4 * n;
                    if (e0 || e3) *(f32x4*)(EB + ((size_t)(u.pm * 4 + (e0 ? fr : fr - 12))) * NUP + ec) = ev;
                }
        }
#pragma unroll
        for (int n = 0; n < 2; ++n)
#pragma unroll
            for (int ep = 0; ep < 2; ++ep) {
                const int ci = cl + 4 * n + 2 * ep;
                if (ep == 0 && n == 0) __builtin_amdgcn_sched_barrier(0);
                f32x2 w0[2], w1[2], w2[2], bb[2];
#pragma unroll
                for (int bj = 0; bj < 2; ++bj) { w0[bj] = *(const LAS f32x2*)(CST + 128 * bj + ci); w1[bj] = *(const LAS f32x2*)(CST + 256 + 128 * bj + ci); w2[bj] = *(const LAS f32x2*)(CST + 512 + 128 * bj + ci); bb[bj] = *(const LAS f32x2*)(CST + 768 + 128 * bj + ci); }
#pragma unroll
                for (int ai = 0; ai < 2; ++ai) {
                    const int q = 2 * ai + wr;
                    f32x2 cv[2][4];
#pragma unroll
                    for (int bj = 0; bj < 2; ++bj) {
                        f32x2 top = *(const LAS f32x2*)(X + ((q > 0 ? q - 1 : 0) * 2 + 1) * 256 + 128 * bj + ci) * RS[q > 0 ? 64 * q - 1 : 0]; if (q == 0) top = (f32x2){0.f, 0.f};
                        f32x2 bot = *(const LAS f32x2*)(X + ((q < 3 ? q + 1 : 3) * 2 + 0) * 256 + 128 * bj + ci) * RS[q < 3 ? 64 * q + 64 : 255]; if (q == 3) bot = (f32x2){0.f, 0.f};
                        f32x2 v[4];
#pragma unroll
                        for (int m = 0; m < 4; ++m) v[m] = (f32x2){acc[ai][bj][m][n][2 * ep], acc[ai][bj][m][n][2 * ep + 1]};
#pragma unroll
                        for (int m = 0; m < 4; ++m) {
                            f32x2 pv, nv;
#pragma unroll
                            for (int c = 0; c < 2; ++c) {
                                const float po = (m == 0) ? top[c] : dpp_rot<0x121>(v[m > 0 ? m - 1 : 0][c]);
                                pv[c] = dpp_upd<0x111>(po, v[m][c]);
                                const float no = (m == 3) ? bot[c] : dpp_rot<0x12f>(v[m < 3 ? m + 1 : 3][c]);
                                nv[c] = dpp_upd<0x101>(no, v[m][c]);
                            }
                            cv[bj][m] = bb[bj] + w0[bj] * pv + w1[bj] * v[m] + w2[bj] * nv;
                        }
                    }
#pragma unroll
                    for (int m = 0; m < 4; ++m) { const f32x2 r = gelu_t2(cv[0][m]) * cv[1][m]; acc[ai][0][m][n][2 * ep] = r[0]; acc[ai][0][m][n][2 * ep + 1] = r[1]; }
                }
            }
#pragma unroll
        for (int ai = 0; ai < 2; ++ai)
#pragma unroll
            for (int m = 0; m < 4; ++m) {
                const int tok = u.pm * 256 + 128 * ai + 64 * wr + 16 * m + fr;
                *(u32x4*)(act + (size_t)tok * DFF + u.pn * 128 + cl) = pack8(acc[ai][0][m][0], acc[ai][0][m][1]);
            }
    }
};

__device__ __forceinline__ void s5_lam(const Params& P, int dir, int g, int p, float& ar, float& ai, float& lr, float& li) {
    const float dt = expf(P.log_dt[dir * 32 + g]); const int i = (dir * 32 + g) * 64 + p; lr = P.lam_re[i]; li = P.lam_im[i]; ar = lr * dt; ai = li * dt;
}
__device__ __forceinline__ void cpowf_(float ar, float ai, float e, float& re, float& im) { const float mg = expf(ar * e); float s, c; sincosf(ai * e, &s, &c); re = mg * c; im = mg * s; }
__device__ __forceinline__ void s5_coef(float ar, float ai, float lr, float li, float& cr, float& ci) {
    float s, c; sincosf(ai, &s, &c); const float em1 = expm1f(ar), sh = sinf(0.5f * ai);
    const float nr = em1 * c - 2.0f * sh * sh, ni = (em1 + 1.0f) * s, den = lr * lr + li * li;
    cr = (nr * lr + ni * li) / den; ci = (ni * lr - nr * li) / den;
}

__device__ __forceinline__ void p0_transposes(const Params& P, unsigned char* shm, const int tid, const int bid, const int gsz, const int sel) {
    unsigned char* ws = P.ws;
    bf16_t* WinT = (bf16_t*)(ws + O_WIN); bf16_t* WgluT = (bf16_t*)(ws + O_WGLU); bf16_t* WoutT = (bf16_t*)(ws + O_WOUT); bf16_t* WupT = (bf16_t*)(ws + O_WUP); bf16_t* WdnT = (bf16_t*)(ws + O_WDN);
    {
        float* tile = (float*)shm;
        constexpr int T0 = 16 * 8, T1 = 8 * 8, T2 = 8 * 16, T3 = 16 * 88, T4 = 44 * 16; const int TT = (sel == 1) ? T1 + T2 : (sel >= 2) ? T3 / 2 + T4 / 2 : T0;
        auto decode = [&](int vt, const float*& src, int& lds_, bf16_t*& dst, int& ldd, int& k0, int& n0, int& sn0, int& mode) {
            const int hf = (sel == 3) ? 1 : 0;
            int r = (sel == 1) ? T0 + vt : (sel >= 2) ? (vt < T3 / 2 ? vt + T0 + T1 + T2 + hf * (T3 / 2) : (vt - T3 / 2) + T0 + T1 + T2 + T3 + hf * (T4 / 2)) : vt, nkt; mode = 0;
            if (r < T0) { src = P.w_in; lds_ = 1024; dst = WinT; ldd = 1024; nkt = 16; }
            else if ((r -= T0) < T1) { src = P.w_glu; lds_ = 512; dst = WgluT; ldd = 512; nkt = 8; }
            else if ((r -= T1) < T2) { src = P.w_out; lds_ = 1024; dst = WoutT; ldd = 1024; nkt = 8; }
            else if ((r -= T2) < T3) { src = P.w_up; lds_ = NUP; dst = WupT; ldd = 1024; nkt = 16; mode = 1; }
            else { r -= T3; src = P.w_down; lds_ = 1024; dst = WdnT; ldd = DFF; nkt = 44; }
            k0 = (r % nkt) * 64; n0 = (r / nkt) * 64;
            sn0 = n0; if (mode == 1) { const int pn = n0 >> 8, bj = (n0 >> 7) & 1, r0 = n0 & 127; sn0 = bj * DFF + pn * 128 + r0; }
        };
        const int rr0 = tid >> 4, c4 = (tid & 15) * 4;
        f32x4 pv[2];
        { int it = bid; if (it < TT) { const float* src; int lds_, ldd, k0, n0, sn0, mode; bf16_t* dst; decode(it, src, lds_, dst, ldd, k0, n0, sn0, mode);
#pragma unroll
            for (int i = 0; i < 2; ++i) { pv[i] = *(const f32x4*)(src + (size_t)(k0 + rr0 + 32 * i) * lds_ + sn0 + c4); if (mode == 1) pv[i] = pv[i] * P.g_ffn[k0 + rr0 + 32 * i]; } } }
        for (int it = bid; it < TT; it += gsz) {
            const float* src; int lds_, ldd, k0, n0, sn0, mode; bf16_t* dst; decode(it, src, lds_, dst, ldd, k0, n0, sn0, mode);
            __syncthreads();
#pragma unroll
            for (int i = 0; i < 2; ++i) { const int rr = rr0 + 32 * i; tile[rr * 65 + c4] = pv[i][0]; tile[rr * 65 + c4 + 1] = pv[i][1]; tile[rr * 65 + c4 + 2] = pv[i][2]; tile[rr * 65 + c4 + 3] = pv[i][3]; }
            __syncthreads();
            if (it + gsz < TT) { const float* src2; int lds2, ldd2, k02, n02, sn02, mode2; bf16_t* dst2; decode(it + gsz, src2, lds2, dst2, ldd2, k02, n02, sn02, mode2);
#pragma unroll
                for (int i = 0; i < 2; ++i) { pv[i] = *(const f32x4*)(src2 + (size_t)(k02 + rr0 + 32 * i) * lds2 + sn02 + c4); if (mode2 == 1) pv[i] = pv[i] * P.g_ffn[k02 + rr0 + 32 * i]; } }
            { const int nl = tid >> 3, kc = (tid & 7) * 8; const float* tp = tile + kc * 65 + nl;
                u32x4 w; w.x = cvt_pk_bf16(tp[0], tp[65]); w.y = cvt_pk_bf16(tp[2 * 65], tp[3 * 65]); w.z = cvt_pk_bf16(tp[4 * 65], tp[5 * 65]); w.w = cvt_pk_bf16(tp[6 * 65], tp[7 * 65]);
                *(u32x4*)(dst + (size_t)(n0 + nl) * ldd + k0 + kc) = w; }
        }
        __syncthreads();
    }
}
__device__ __forceinline__ void p0_c2(const Params& P, unsigned char* shm, const int tid, const int bid, const int gsz) {
    bf16_t* WoutT = (bf16_t*)(P.ws + O_WOUT);
    {
        float* wo = (float*)shm; float* wfT = wo + 128 * 64;
        for (int it = bid; it < 64; it += gsz) {
            const int h = it >> 4, n0 = (it & 15) * 64;
            __syncthreads();
            for (int i = 0; i < 4; ++i) { const int idx = (tid + 512 * i) * 4, d = idx >> 6, n = idx & 63; *(f32x4*)(wo + idx) = *(const f32x4*)(P.w_out + (size_t)(512 + h * 128 + d) * 1024 + n0 + n); }
            for (int i = 0; i < 32; ++i) { const int idx = tid + 512 * i, d = idx >> 7, c = idx & 127; wfT[idx] = P.w_fourier[(size_t)(h * 128 + c) * 128 + d]; }
            __syncthreads();
            const int c0 = (tid & 31) * 4, nn = (tid >> 5) * 4; f32x4 a[4];
#pragma unroll
            for (int i = 0; i < 4; ++i) a[i] = (f32x4){0.f, 0.f, 0.f, 0.f};
            for (int d = 0; d < 128; ++d) { const f32x4 f = *(const f32x4*)(wfT + d * 128 + c0), w = *(const f32x4*)(wo + d * 64 + nn);
#pragma unroll
                for (int i = 0; i < 4; ++i) a[i] += w[i] * f; }
#pragma unroll
            for (int i = 0; i < 4; ++i) { u32x2 w; w.x = cvt_pk_bf16(a[i][0], a[i][1]); w.y = cvt_pk_bf16(a[i][2], a[i][3]); *(u32x2*)(WoutT + (size_t)(n0 + nn + i) * 1024 + 512 + h * 128 + c0) = w; }
        }
        __syncthreads();
    }
}

__device__ __forceinline__ void phase0(const Params& P, unsigned char* shm, const int bid, const int gsz) {
    unsigned char* ws = P.ws;
    int tid_ = threadIdx.x; asm volatile("" : "+v"(tid_));
    const int tid = tid_, wid = tid >> 6, lane = tid & 63;
    const int gtid = bid * 512 + tid, nthr = gsz * 512;
    bf16_t* WinT = (bf16_t*)(ws + O_WIN); bf16_t* WgluT = (bf16_t*)(ws + O_WGLU); bf16_t* WoutT = (bf16_t*)(ws + O_WOUT); bf16_t* WupT = (bf16_t*)(ws + O_WUP); bf16_t* WdnT = (bf16_t*)(ws + O_WDN);
    auto rmsnorm_rows = [&]()     {
        bf16_t* xn = (bf16_t*)(ws + O_XN);
        f32x4 gm[4];
#pragma unroll
        for (int i = 0; i < 4; ++i) gm[i] = ((const f32x4*)P.g_mix)[lane + 64 * i];
        for (int row0 = (bid * 8 + wid) * 4; row0 < NTOK; row0 += gsz * 8 * 4) {
            f32x4 v[4][4];
#pragma unroll
            for (int r = 0; r < 4; ++r)
#pragma unroll
                for (int i = 0; i < 4; ++i) v[r][i] = ((const f32x4*)(P.x + (size_t)(row0 + r) * DM))[lane + 64 * i];
#pragma unroll
            for (int r = 0; r < 4; ++r) {
                float s = 0.f;
#pragma unroll
                for (int i = 0; i < 4; ++i) s += (v[r][i][0] * v[r][i][0] + v[r][i][1] * v[r][i][1]) + (v[r][i][2] * v[r][i][2] + v[r][i][3] * v[r][i][3]);
#pragma unroll
                for (int o = 32; o; o >>= 1) s += __shfl_xor(s, o);
                const float rs = rsqrtf(s * (1.0f / DM) + EPS);
#pragma unroll
                for (int i = 0; i < 4; ++i) { const f32x4 t = v[r][i] * rs * gm[i]; u32x2 w; w.x = cvt_pk_bf16(t[0], t[1]); w.y = cvt_pk_bf16(t[2], t[3]);
                    *(u32x2*)(xn + (size_t)(row0 + r) * DM + (lane + 64 * i) * 4) = w; }
            }
        }
    };
    if (bid & 1) rmsnorm_rows();
    p0_transposes(P, shm, tid, bid, gsz, 0);
    {
        float* wt = (float*)shm; float* cs = wt + 16 * 128; float* sn = cs + 128;
        for (int it = bid; it < 256; it += gsz) {
            const int h = it >> 6, k0 = (it & 63) * 16;
            __syncthreads();
            if (tid < 128) { float s, c; sincospif((float)tid * (1.0f / 64.0f), &s, &c); cs[tid] = c * 0.08838834764831845f; sn[tid] = s * 0.08838834764831845f; }
            { const int row = tid >> 5, c4 = tid & 31; *(f32x4*)(wt + row * 128 + c4 * 4) = *(const f32x4*)(P.w_in + (size_t)(k0 + row) * 1024 + 512 + h * 128 + c4 * 4); }
            __syncthreads();
            const int r = tid & 127, ks = tid >> 7, j = (r <= 64) ? r : r - 64; const float* tb = (r <= 64) ? cs : sn;
            float a[4];
#pragma unroll
            for (int kk = 0; kk < 4; ++kk) a[kk] = 0.f;
            for (int c = 0; c < 128; c += 4) { const float t0 = tb[(c * j) & 127], t1 = tb[((c + 1) * j) & 127], t2 = tb[((c + 2) * j) & 127], t3 = tb[((c + 3) * j) & 127];
#pragma unroll
                for (int kk = 0; kk < 4; ++kk) { const f32x4 w4 = *(const f32x4*)(wt + (ks * 4 + kk) * 128 + c); a[kk] += (w4[0] * t0 + w4[1] * t1) + (w4[2] * t2 + w4[3] * t3); } }
            u32x2 w; w.x = cvt_pk_bf16(a[0], a[1]); w.y = cvt_pk_bf16(a[2], a[3]);
            *(u32x2*)(WinT + (size_t)(512 + h * 128 + r) * 1024 + k0 + ks * 4) = w;
        }
        __syncthreads();
    }
    {
        bf16_t* AL = (bf16_t*)(ws + O_AL); float* tab = (float*)shm;
        __syncthreads();
        for (int i = tid; i < 2048; i += 512) tab[i] = cospif((float)i * (1.0f / 1024.0f)) * 0.02209708691207961f;
        __syncthreads();
        for (int it = gtid; it < (1 << 19); it += nthr) {
            const int l8 = (it & 255) * 8, k = (it >> 8) & 1023, sc = it >> 18; float v[8];
#pragma unroll
            for (int e = 0; e < 8; ++e) v[e] = tab[(k * (l8 + e) - (sc ? 512 : 0)) & 2047];
            u32x4 w; w.x = cvt_pk_bf16(v[0], v[1]); w.y = cvt_pk_bf16(v[2], v[3]); w.z = cvt_pk_bf16(v[4], v[5]); w.w = cvt_pk_bf16(v[6], v[7]);
            *(u32x4*)(AL + ((size_t)(sc * 1024 + k)) * 2048 + l8) = w;
        }
        __syncthreads();
    }
    {
        bf16_t* Wst = (bf16_t*)(ws + O_WST); bf16_t* Wy = (bf16_t*)(ws + O_WY); float* Kt = (float*)(ws + O_KTAB);
        float* Lr = (float*)shm; float* Li = Lr + 33 * 64; float* Fr = Li + 33 * 64; float* Fi = Fr + 64; float* Cr = Fi + 64; float* Ci = Cr + 1024; float* Br = Ci + 1024; float* Bi = Br + 1024;
        for (int it = bid; it < 256; it += gsz) {
            const int qt = it & 3, dir = (it >> 2) & 1, g = it >> 3;
            __syncthreads();
            { const int p = tid & 63, dl = tid >> 6; float ar, ai, lr, li; s5_lam(P, dir, g, p, ar, ai, lr, li);
              for (int e = dl; e < 33; e += 8) { float pr, pi; cpowf_(ar, ai, (float)e, pr, pi); Lr[e * 64 + p] = pr; Li[e * 64 + p] = pi; }
              if (dl == 0) { float cr, ci; s5_coef(ar, ai, lr, li, cr, ci); Fr[p] = cr; Fi[p] = ci; }
              const size_t cb0 = (size_t)(dir * 32 + g) * 1024;
#pragma unroll
              for (int i = 0; i < 2; ++i) { const int idx = tid + 512 * i; Cr[idx] = P.c_re[cb0 + idx]; Ci[idx] = P.c_im[cb0 + idx]; Br[idx] = P.b_re[cb0 + idx]; Bi[idx] = P.b_im[cb0 + idx]; } }
            __syncthreads();
#pragma unroll
            for (int j = 0; j < 2; ++j) {
                const int idx = tid + 512 * j, sl = idx & 7, rowi = idx >> 3, part = rowi >> 6, p = rowi & 63, s = qt * 8 + sl, e = dir ? s : 31 - s;
                const float Er = Lr[e * 64 + p] * Fr[p] - Li[e * 64 + p] * Fi[p], Ei = Lr[e * 64 + p] * Fi[p] + Li[e * 64 + p] * Fr[p];
                float o[16];
#pragma unroll
                for (int h = 0; h < 16; ++h) o[h] = part ? (Er * Bi[p * 16 + h] + Ei * Br[p * 16 + h]) : (Er * Br[p * 16 + h] - Ei * Bi[p * 16 + h]);
                u32x4 w0, w1; w0.x = cvt_pk_bf16(o[0], o[1]); w0.y = cvt_pk_bf16(o[2], o[3]); w0.z = cvt_pk_bf16(o[4], o[5]); w0.w = cvt_pk_bf16(o[6], o[7]);
                w1.x = cvt_pk_bf16(o[8], o[9]); w1.y = cvt_pk_bf16(o[10], o[11]); w1.z = cvt_pk_bf16(o[12], o[13]); w1.w = cvt_pk_bf16(o[14], o[15]);
                u32x4* d = (u32x4*)(Wst + ((size_t)(g * 256 + dir * 128 + rowi)) * 512 + s * 16); d[0] = w0; d[1] = w1;
            }
            { const int p = tid & 63, t = qt * 8 + (tid >> 6), e = dir ? 32 - t : t + 1; const float pr = Lr[e * 64 + p], pi = Li[e * 64 + p];
#pragma unroll
              for (int h = 0; h < 16; ++h) { const float cr = Cr[h * 64 + p], ci = Ci[h * 64 + p]; bf16_t* d = Wy + ((size_t)(g * 512 + t * 16 + h)) * UK + 512 + dir * 128 + p;
                  d[0] = f2bf(cr * pr - ci * pi); d[64] = f2bf(-(cr * pi + ci * pr)); } }
            { const int o = tid & 255, h = o >> 4, h2 = o & 15, dh = tid >> 8; float a[4] = {0.f, 0.f, 0.f, 0.f};
              for (int p = 0; p < 64; ++p) {
                  const float cr = Cr[h * 64 + p], ci = Ci[h * 64 + p], xr = cr * Fr[p] - ci * Fi[p], xi = cr * Fi[p] + ci * Fr[p];
                  const float br = Br[p * 16 + h2], bi = Bi[p * 16 + h2], mr = xr * br - xi * bi, mi = xr * bi + xi * br;
#pragma unroll
                  for (int j = 0; j < 4; ++j) { const int d = qt * 8 + dh * 4 + j; a[j] += mr * Lr[d * 64 + p] - mi * Li[d * 64 + p]; }
              }
#pragma unroll
              for (int j = 0; j < 4; ++j) Kt[((size_t)((g * 2 + dir) * 32 + qt * 8 + dh * 4 + j)) * 256 + o] = a[j]; }
        }
        __syncthreads();
    }
    if (!(bid & 1)) rmsnorm_rows();
}

__device__ __forceinline__ void phase3(const Params& P, const int bid, const int gsz) {
    int tid_ = threadIdx.x; asm volatile("" : "+v"(tid_));
    unsigned char* ws = P.ws; const int gtid = bid * 512 + tid_, nthr = gsz * 512;
    bf16_t* U = (bf16_t*)(ws + O_U); const float* S = (const float*)(ws + O_SLOC);
    for (int it = gtid; it < 32 * 16 * 2 * 64; it += nthr) {
        const int p = it & 63, dir = (it >> 6) & 1, b = (it >> 7) & 15, g = it >> 11;
        float ar, ai, lr, li, tr, ti; s5_lam(P, dir, g, p, ar, ai, lr, li); cpowf_(ar, ai, 32.0f, tr, ti);
        float hr = 0.f, hi = 0.f;
        for (int c0 = 0; c0 < 64; c0 += 16) {
            float sr[16], si[16];
#pragma unroll
            for (int j = 0; j < 16; ++j) { const int c = dir ? 63 - (c0 + j) : c0 + j; const float* sp = S + ((size_t)(g * 1024 + b * 64 + c)) * 256 + dir * 128 + p; sr[j] = sp[0]; si[j] = sp[64]; }
#pragma unroll
            for (int j = 0; j < 16; ++j) { const int c = dir ? 63 - (c0 + j) : c0 + j; bf16_t* up = U + ((size_t)(g * 1024 + b * 64 + c)) * UK + 512 + dir * 128 + p;
                up[0] = f2bf(hr); up[64] = f2bf(hi);
                const float nr = tr * hr - ti * hi + sr[j], ni = tr * hi + ti * hr + si[j]; hr = nr; hi = ni; }
        }
    }
    {
        const bf16_t* EO = (const bf16_t*)(ws + O_Z); bf16_t* cat = (bf16_t*)(ws + O_CAT); const bf16_t* PT = (const bf16_t*)(ws + O_PQT);
        for (int it = gtid; it < 1024 * 64 * 8; it += nthr) {
            const int j0 = (it & 7) * 8, bh = (it >> 3) & 63, k = it >> 9, b = bh >> 2, h = bh & 3;
            const u32x4 e = *(const u32x4*)(EO + (size_t)k * 4352 + bh * 64 + j0); u32x4 o = *(const u32x4*)(EO + ((size_t)(1024 + k)) * 4352 + bh * 64 + j0);
            if (j0 == 0) o.x &= 0xffff0000u;
            float lo[8], hi[8];
            lo[0] = bflo(e.x) - bflo(o.x); hi[0] = bflo(e.x) + bflo(o.x); lo[1] = bfhi(e.x) - bfhi(o.x); hi[1] = bfhi(e.x) + bfhi(o.x);
            lo[2] = bflo(e.y) - bflo(o.y); hi[2] = bflo(e.y) + bflo(o.y); lo[3] = bfhi(e.y) - bfhi(o.y); hi[3] = bfhi(e.y) + bfhi(o.y);
            lo[4] = bflo(e.z) - bflo(o.z); hi[4] = bflo(e.z) + bflo(o.z); lo[5] = bfhi(e.z) - bfhi(o.z); hi[5] = bfhi(e.z) + bfhi(o.z);
            lo[6] = bflo(e.w) - bflo(o.w); hi[6] = bflo(e.w) + bflo(o.w); lo[7] = bfhi(e.w) - bfhi(o.w); hi[7] = bfhi(e.w) + bfhi(o.w);
            bf16_t* ra = cat + ((size_t)(b * 2048 + k)) * 1024 + 512 + h * 128; bf16_t* rb = cat + ((size_t)(b * 2048 + 2048 - k)) * 1024 + 512 + h * 128;
            u32x4 wl, wh; wl.x = cvt_pk_bf16(lo[0], lo[1]); wl.y = cvt_pk_bf16(lo[2], lo[3]); wl.z = cvt_pk_bf16(lo[4], lo[5]); wl.w = cvt_pk_bf16(lo[6], lo[7]);
            wh.x = cvt_pk_bf16(hi[0], hi[1]); wh.y = cvt_pk_bf16(hi[2], hi[3]); wh.z = cvt_pk_bf16(hi[4], hi[5]); wh.w = cvt_pk_bf16(hi[6], hi[7]);
            *(u32x4*)(ra + j0) = wl;
            if (k > 0) *(u32x4*)(rb + j0) = wh;
#pragma unroll
            for (int i = 0; i < 8; ++i) { const int j = j0 + i; if (j > 0) { ra[128 - j] = f2bf(hi[i]); if (k > 0) rb[128 - j] = f2bf(lo[i]); } }
        }
        for (int it = gtid; it < 1024 * 64; it += nthr) {
            const int bh = it & 63, k = it >> 6, b = bh >> 2, h = bh & 3; const bf16_t v = EO[(size_t)k * 4352 + 4096 + bh];
            cat[((size_t)(b * 2048 + k)) * 1024 + 512 + h * 128 + 64] = v;
            if (k > 0) cat[((size_t)(b * 2048 + 2048 - k)) * 1024 + 512 + h * 128 + 64] = v;
        }
    }
}

__device__ __forceinline__ void phase2x(const Params& P, const int bid, const int gsz) {
    int tid_ = threadIdx.x; asm volatile("" : "+v"(tid_));
    unsigned char* ws = P.ws; const int gtid = bid * 512 + tid_, nthr = gsz * 512;
    {
        bf16_t* cat = (bf16_t*)(ws + O_CAT); const bf16_t* PT = (const bf16_t*)(ws + O_PQT);
        const int wid = tid_ >> 6, lane = tid_ & 63;
        for (int n = bid * 8 + wid; n < 64 * 65; n += gsz * 8) {
            const int bh = n / 65, j = n % 65, b = bh >> 2, h = bh & 3;
            const u32x4* pp = (const u32x4*)(PT + ((size_t)(j < 64 ? bh * 64 + j : 4096 + bh)) * 2048); float s = 0.f;
#pragma unroll
            for (int i = 0; i < 4; ++i) { const u32x4 v = pp[lane + 64 * i]; s += (bflo(v.x) - bfhi(v.x)) + (bflo(v.y) - bfhi(v.y)) + (bflo(v.z) - bfhi(v.z)) + (bflo(v.w) - bfhi(v.w)); }
#pragma unroll
            for (int o = 32; o; o >>= 1) s += __shfl_xor(s, o);
            if (lane == 0) { const bf16_t v = f2bf(s * 0.02209708691207961f); bf16_t* rr = cat + ((size_t)(b * 2048 + 1024)) * 1024 + 512 + h * 128; rr[j] = v; if (j > 0 && j < 64) rr[128 - j] = v; }
        }
    }
    bf16_t* Wy = (bf16_t*)(ws + O_WY); const float* Kt = (const float*)(ws + O_KTAB);
    for (int it = gtid; it < 32 * 32 * 16 * 32; it += nthr) {
        const int s = it & 31, h = (it >> 5) & 15, t = (it >> 9) & 31, g = it >> 14;
        float o[16];
        if (s < t) { const float* k = Kt + ((size_t)((g * 2 + 0) * 32 + (t - s))) * 256 + h * 16;
#pragma unroll
            for (int j = 0; j < 16; ++j) o[j] = k[j]; }
        else if (s > t) { const float* k = Kt + ((size_t)((g * 2 + 1) * 32 + (s - t))) * 256 + h * 16;
#pragma unroll
            for (int j = 0; j < 16; ++j) o[j] = k[j]; }
        else { const float* k0 = Kt + ((size_t)((g * 2 + 0) * 32)) * 256 + h * 16; const float* k1 = Kt + ((size_t)((g * 2 + 1) * 32)) * 256 + h * 16; const float dd = P.ssm_d[g * 16 + h];
#pragma unroll
            for (int j = 0; j < 16; ++j) o[j] = k0[j] + k1[j] + (j == h ? dd : 0.f); }
        u32x4 w0, w1; w0.x = cvt_pk_bf16(o[0], o[1]); w0.y = cvt_pk_bf16(o[2], o[3]); w0.z = cvt_pk_bf16(o[4], o[5]); w0.w = cvt_pk_bf16(o[6], o[7]);
        w1.x = cvt_pk_bf16(o[8], o[9]); w1.y = cvt_pk_bf16(o[10], o[11]); w1.z = cvt_pk_bf16(o[12], o[13]); w1.w = cvt_pk_bf16(o[14], o[15]);
        u32x4* d = (u32x4*)(Wy + ((size_t)(g * 512 + t * 16 + h)) * UK + s * 16); d[0] = w0; d[1] = w1;
    }
}

__device__ __forceinline__ void phase8(const Params& P, const int bid, const int gsz) {
    int tid_ = threadIdx.x; asm volatile("" : "+v"(tid_));
    unsigned char* ws = P.ws; const int gtid = bid * 512 + tid_, nthr = gsz * 512;
    const float* EB = (const float*)(ws + O_EB); bf16_t* act = (bf16_t*)(ws + O_ACT);
    for (int it = gtid; it < 128 * NUP; it += nthr) {
        const int pm = it / NUP, rem = it % NUP, which = rem / DFF, ch = rem % DFF;
        if ((pm & 7) == 7) continue;
        const float* e0 = EB + (size_t)(pm * 4) * NUP; const float* e1 = EB + (size_t)((pm + 1) * 4) * NUP;
        const float* rp = which ? e0 + 3 * NUP : e0 + 2 * NUP; const float* rc = which ? e1 : e0 + 3 * NUP; const float* rn = which ? e1 + NUP : e1;
        float cv[2];
#pragma unroll
        for (int bj = 0; bj < 2; ++bj) { const int col = bj * DFF + ch; cv[bj] = P.conv_b[col] + P.conv_w[col] * rp[col] + P.conv_w[NUP + col] * rc[col] + P.conv_w[2 * NUP + col] * rn[col]; }
        act[(size_t)(pm * 256 + 255 + which) * DFF + ch] = f2bf(gelu_t(cv[0]) * cv[1]);
    }
}

__device__ __forceinline__ void phase10(const Params& P, const int bid, const int gsz) {
    int tid_ = threadIdx.x; asm volatile("" : "+v"(tid_));
    const int wid = tid_ >> 6, lane = tid_ & 63; const float* ss = (const float*)(P.ws + O_SS2); const bf16_t* H2 = (const bf16_t*)(P.ws + O_CAT);
    for (int row = bid * 8 + wid; row < NTOK; row += gsz * 8) {
        const u32x4* p = (const u32x4*)(H2 + (size_t)row * DM); f32x4* d = (f32x4*)(P.out + (size_t)row * DM);
        float s = (lane < 4) ? ss[(size_t)row * 4 + lane] : 0.f;
#pragma unroll
        for (int o = 32; o; o >>= 1) s += __shfl_xor(s, o);
        const float rs = rsqrtf(s * (1.0f / DM) + EPS);
#pragma unroll
        for (int i = 0; i < 2; ++i) { const u32x4 z = p[lane + 64 * i]; const f32x4 g0 = ((const f32x4*)P.g_final)[(lane + 64 * i) * 2], g1 = ((const f32x4*)P.g_final)[(lane + 64 * i) * 2 + 1];
            d[(lane + 64 * i) * 2] = (f32x4){bflo(z.x), bfhi(z.x), bflo(z.y), bfhi(z.y)} * rs * g0; d[(lane + 64 * i) * 2 + 1] = (f32x4){bflo(z.z), bfhi(z.z), bflo(z.w), bfhi(z.w)} * rs * g1; }
    }
}

struct EpiNull {
    static constexpr bool PERM = true, HAS_PRE = false;
    float* dummy;
    __device__ __forceinline__ void operator()(const Acc& acc, const Unit& u, int wr, int wc, int fr, int fq) const {
        f32x4 s = {0.f, 0.f, 0.f, 0.f};
#pragma unroll
        for (int ai = 0; ai < 2; ++ai)
#pragma unroll
            for (int bj = 0; bj < 2; ++bj)
#pragma unroll
                for (int m = 0; m < 4; ++m)
#pragma unroll
                    for (int n = 0; n < 2; ++n) s += acc[ai][bj][m][n];
        if (s[0] + s[1] + s[2] + s[3] == 12345.678f) dummy[threadIdx.x] = s[0];
    }
};

__device__ __forceinline__ void run_phase(const Params& P0, int ph, const bool dummy, unsigned char* shm) {
    Params P = P0;
#define OPAQUE_G(p) do { __attribute__((address_space(1))) char* _g = (__attribute__((address_space(1))) char*)(p); asm volatile("" : "+s"(_g)); p = (decltype(p))_g; } while (0)
    OPAQUE_G(P.x); OPAQUE_G(P.g_mix); OPAQUE_G(P.w_in); OPAQUE_G(P.lam_re); OPAQUE_G(P.lam_im); OPAQUE_G(P.log_dt); OPAQUE_G(P.b_re); OPAQUE_G(P.b_im); OPAQUE_G(P.c_re); OPAQUE_G(P.c_im); OPAQUE_G(P.ssm_d); OPAQUE_G(P.w_glu);
    OPAQUE_G(P.b_glu); OPAQUE_G(P.w_fourier); OPAQUE_G(P.w_out); OPAQUE_G(P.g_ffn); OPAQUE_G(P.w_up); OPAQUE_G(P.conv_w); OPAQUE_G(P.conv_b); OPAQUE_G(P.w_down); OPAQUE_G(P.g_final); OPAQUE_G(P.out); OPAQUE_G(P.ws);
#undef OPAQUE_G
    int bid = blockIdx.x, gsz = gridDim.x; asm volatile("" : "+s"(bid), "+s"(gsz));
    unsigned char* ws = P.ws; LAS unsigned char* lds = (LAS unsigned char*)shm;
    Order S; S.G = gsz; S.c = bid; S.nBatch = 1; S.bA = 0; S.bB = 0;
    switch (ph) {
    case 0: phase0(P, shm, bid, gsz); break;
    case 1: { S.A = (const char*)(ws + O_XN); S.B = (const char*)(ws + O_WIN); S.nM = 128; S.nN = 4; S.sA = (size_t)256 * 1024 * 2; S.sB = (size_t)256 * 1024 * 2;

#if defined(REPEAT_PH) && PROBE_NULL && (REPEAT_PH == 1)
        if (dummy) { EpiNull E0{(float*)(ws + O_EB)}; gemm_phase(lds, 1024, 1024, 1024, S, E0); break; }
#endif
        EpiIn E{(bf16_t*)(ws + O_U), (bf16_t*)(ws + O_PQT)}; gemm_phase(lds, 1024, 1024, 1024, S, E); } break;
    case 2: { S.A = (const char*)(ws + O_U); S.B = (const char*)(ws + O_WST); S.nM = 4; S.nN = 1; S.nBatch = 32; S.bA = (size_t)1024 * UK * 2; S.bB = (size_t)256 * 512 * 2; S.sA = (size_t)256 * UK * 2; S.sB = (size_t)256 * 512 * 2;
        EpiSloc E{(float*)(ws + O_SLOC)}; gemm_phase(lds, 512, UK, 512, S, E);
        Order S2; S2.G = gsz; S2.c = (gsz >= 136) ? (bid + 136) % gsz : bid; S2.nBatch = 2; S2.bA = (size_t)1024 * 2048 * 2; S2.bB = (size_t)4352 * 2048 * 2; S2.A = (const char*)(ws + O_AL); S2.B = (const char*)(ws + O_PQT); S2.nM = 4; S2.nN = 17; S2.sA = (size_t)256 * 2048 * 2; S2.sB = (size_t)256 * 2048 * 2;
        EpiDft E2{(bf16_t*)(ws + O_Z)}; gemm_phase(lds, 2048, 2048, 2048, S2, E2);
        { int tid_ = threadIdx.x; asm volatile("" : "+v"(tid_));
          if (gsz >= 200) { if (bid < gsz - 136) { phase2x(P, bid, gsz - 136); p0_transposes(P, shm, tid_, bid, gsz - 136, 1); p0_c2(P, shm, tid_, bid, gsz - 136); } }
          else { phase2x(P, bid, gsz); p0_transposes(P, shm, tid_, bid, gsz, 1); p0_c2(P, shm, tid_, bid, gsz); } } } break;
    case 3: phase3(P, bid, gsz); break;
    case 4: { S.A = (const char*)(ws + O_U); S.B = (const char*)(ws + O_WY); S.nM = 4; S.nN = 2; S.nBatch = 32; S.bA = (size_t)1024 * UK * 2; S.bB = (size_t)512 * UK * 2; S.sA = (size_t)256 * UK * 2; S.sB = (size_t)256 * UK * 2;
        EpiY E{(bf16_t*)(ws + O_Z)}; gemm_phase(lds, UK, UK, UK, S, E); } break;
    case 5: { S.A = (const char*)(ws + O_Z); S.B = (const char*)(ws + O_WGLU); S.nM = 128; S.nN = 2; S.sA = (size_t)256 * 512 * 2; S.sB = (size_t)256 * 512 * 2;
        EpiGlu E{(const bf16_t*)(ws + O_Z), P.b_glu, (bf16_t*)(ws + O_CAT)}; gemm_phase(lds, 512, 512, 512, S, E); } break;
    case 6: { S.A = (const char*)(ws + O_CAT); S.B = (const char*)(ws + O_WOUT); S.nM = 128; S.nN = 4; S.sA = (size_t)256 * 1024 * 2; S.sB = (size_t)256 * 1024 * 2;

#if defined(REPEAT_PH) && PROBE_NULL && (REPEAT_PH == 6)
        if (dummy) { EpiNull E0{(float*)(ws + O_EB)}; gemm_phase(lds, 1024, 1024, 1024, S, E0); break; }
#endif
        { int tid_ = threadIdx.x; asm volatile("" : "+v"(tid_));
          const bool stag = (gsz & 1) == 0;
          if (!stag) { p0_transposes(P, shm, tid_, bid, gsz, 2); p0_transposes(P, shm, tid_, bid, gsz, 3); }
          else if (bid & 1) p0_transposes(P, shm, tid_, bid >> 1, gsz >> 1, 2);
          EpiRes<false> E{P.x, (bf16_t*)(ws + O_XN), (float*)(ws + O_SS1), (LAS float*)(lds + STAGE_BYTES)}; gemm_phase(lds, 1024, 1024, 1024, S, E);
          if (stag && !(bid & 1)) p0_transposes(P, shm, tid_, bid >> 1, gsz >> 1, 3); } } break;
    case 7: { S.A = (const char*)(ws + O_XN); S.B = (const char*)(ws + O_WUP); S.nM = 128; S.nN = 22; S.sA = (size_t)256 * 1024 * 2; S.sB = (size_t)256 * 1024 * 2;
#if defined(REPEAT_PH) && PROBE_NULL && (REPEAT_PH == 7)
        if (dummy) { EpiNull E{(float*)(ws + O_EB)}; gemm_phase(lds, 1024, 1024, 1024, S, E); break; }
#endif
        EpiUp E{(const float*)(ws + O_SS1), P.conv_w, P.conv_b, (bf16_t*)(ws + O_ACT), (float*)(ws + O_EB), (LAS float*)(lds + STAGE_BYTES)}; gemm_phase(lds, 1024, 1024, 1024, S, E); } break;
    case 8: phase8(P, bid, gsz); break;
    case 9: { S.A = (const char*)(ws + O_ACT); S.B = (const char*)(ws + O_WDN); S.nM = 128; S.nN = 4; S.sA = (size_t)256 * DFF * 2; S.sB = (size_t)256 * DFF * 2;

#if defined(REPEAT_PH) && PROBE_NULL && (REPEAT_PH == 9)
        if (dummy) { EpiNull E0{(float*)(ws + O_EB)}; gemm_phase(lds, DFF, DFF, DFF, S, E0); break; }
#endif
        if (gsz == 256) { EpiFinal EF{(const bf16_t*)(ws + O_XN), P.out, P.g_final, (float*)(ws + O_SS2), (unsigned*)(ws + O_BAR + 16384), (LAS float*)(lds + STAGE_BYTES)}; gemm_phase(lds, DFF, DFF, DFF, S, EF); break; }
        EpiRes<true> E{(const void*)(ws + O_XN), (bf16_t*)(ws + O_CAT), (float*)(ws + O_SS2), (LAS float*)(lds + STAGE_BYTES)}; gemm_phase(lds, DFF, DFF, DFF, S, E); } break;
    case 10: if (gsz != 256) phase10(P, bid, gsz); break;
    }
}


#define XB_TMO      128
#define XB_XCNT(j)  (256  + 64 * (j))
#define XB_XSUB(j)  (1280 + 64 * (j))
#define XB_XGEN(j)  (2304 + 64 * (j))
#define XB_TOP      3328
#define XB_TOPGEN   3392
#define XCD_BAR_WORDS 3456
#define XB_SPIN_CAP (1u << 22)
__device__ __forceinline__ unsigned xb_ld(unsigned* p)              { return __hip_atomic_load(p, __ATOMIC_RELAXED, __HIP_MEMORY_SCOPE_AGENT); }
__device__ __forceinline__ unsigned xb_add(unsigned* p, unsigned v) { return __hip_atomic_fetch_add(p, v, __ATOMIC_RELAXED, __HIP_MEMORY_SCOPE_AGENT); }
__device__ __forceinline__ unsigned xb_xcc_id() { return (unsigned)__builtin_amdgcn_s_getreg((3 << 11) | 20) & 0xFu; }
#define XB_SPIN(cond, bar) do { unsigned _sp = 0; while (cond) { __builtin_amdgcn_s_sleep(1); \
    if ((++_sp & 255u) == 0u) { if (xb_ld(&(bar)[XB_TMO])) break; if (_sp > XB_SPIN_CAP) { atomicAdd(&(bar)[XB_TMO], 1u); break; } } } } while (0)
struct XcdBarrier { unsigned* bar; unsigned x; volatile LAS unsigned* st; };
__device__ __forceinline__ XcdBarrier xcd_barrier_post(unsigned* bar, volatile LAS unsigned* st) {
    XcdBarrier b; b.bar = bar; b.x = xb_xcc_id(); b.st = st;
    if (threadIdx.x == 0) (void)xb_add(&bar[XB_XCNT(b.x)], 1u);
    return b;
}
__device__ __forceinline__ void xcd_barrier_complete(unsigned* bar, unsigned x, unsigned& nloc, unsigned& nx) {
    const unsigned G = gridDim.x * gridDim.y * gridDim.z;
    unsigned sum, cnt, mine, sp = 0u;
    for (;;) {
        sum = 0u; cnt = 0u; mine = 0u;
#pragma unroll
        for (unsigned j = 0; j < 16; ++j) { const unsigned c = xb_ld(&bar[XB_XCNT(j)]); sum += c; cnt += (c > 0u) ? 1u : 0u; mine = (j == x) ? c : mine; }
        if (sum == G) break;
        __builtin_amdgcn_s_sleep(1);
        if ((++sp & 255u) == 0u) { if (xb_ld(&bar[XB_TMO])) break; if (sp > XB_SPIN_CAP) { atomicAdd(&bar[XB_TMO], 1u); break; } }
    }
    nloc = mine > 0u ? mine : 1u; nx = cnt > 0u ? cnt : 1u;
}
__device__ __forceinline__ void xcd_barrier(const XcdBarrier& b) {
    asm volatile("s_waitcnt vmcnt(0)" ::: "memory");
    __syncthreads();
    if (threadIdx.x == 0) {
        unsigned* bar = b.bar;
        __builtin_amdgcn_s_waitcnt(0);
        unsigned nloc = b.st[0], nx = b.st[1];
        if (nloc == 0u) { xcd_barrier_complete(bar, b.x, nloc, nx); b.st[0] = nloc; b.st[1] = nx; }
        const unsigned old = xb_add(&bar[XB_XSUB(b.x)], 1u);
        const unsigned gen = old / nloc;
        if (old + 1u == (gen + 1u) * nloc) {
            __builtin_amdgcn_fence(__ATOMIC_RELEASE, "agent");
            asm volatile("s_waitcnt vmcnt(0)" ::: "memory");
            const unsigned og = xb_add(&bar[XB_TOP], 1u);
            const unsigned tg = og / nx;
            if (og + 1u == (tg + 1u) * nx) xb_add(&bar[XB_TOPGEN], 1u);
            else XB_SPIN(xb_ld(&bar[XB_TOPGEN]) == tg, bar);
            __builtin_amdgcn_fence(__ATOMIC_ACQUIRE, "agent");
            xb_add(&bar[XB_XGEN(b.x)], 1u);
            asm volatile("s_waitcnt vmcnt(0)" ::: "memory");
        } else {
            XB_SPIN(xb_ld(&bar[XB_XGEN(b.x)]) == gen, bar);
            __builtin_amdgcn_fence(__ATOMIC_ACQUIRE, "agent");
            asm volatile("s_waitcnt vmcnt(0)" ::: "memory");
        }
    }
    __syncthreads();
}

__global__ __launch_bounds__(512, 2) void k_mega(Params P) {
    extern __shared__ __attribute__((aligned(16))) unsigned char shm[];
    volatile LAS unsigned* xst = (volatile LAS unsigned*)((LAS unsigned char*)shm + LDS_BYTES - 16);
    if (threadIdx.x == 0) { xst[0] = 0u; xst[1] = 0u; }
    __syncthreads();
    const XcdBarrier xb = xcd_barrier_post((unsigned*)(P.ws + O_BAR), xst);
#define SEAM(k) xcd_barrier(xb)
    #ifdef REPEAT_PH
    _Pragma("nounroll") for (int i = 0; i < NPH + 1; ++i) { int phv = __builtin_amdgcn_readfirstlane((i <= REPEAT_PH) ? i : i - 1); asm volatile("" : "+s"(phv)); run_phase(P, phv, i == REPEAT_PH, shm); if (i < NPH) SEAM(i); }
#else
    _Pragma("nounroll") for (int ph = 0; ph < NPH; ++ph) { int phv = ph; asm volatile("" : "+s"(phv)); run_phase(P, phv, false, shm); if (ph + 1 < NPH && !(ph == 9 && gridDim.x == 256)) SEAM(ph); }
#endif
}
__global__ __launch_bounds__(512, 2) void k_phase(Params P, int ph) {
    extern __shared__ __attribute__((aligned(16))) unsigned char shm[];
    run_phase(P, ph, false, shm);
}

extern "C" void kernel_launch(void* const* d_in, const int* in_sizes, int n_in, void* d_out, int out_size, void* d_ws, size_t ws_size, hipStream_t stream) {
    static int grid = 0;
    if (grid == 0) {
        if (n_in != 21 || ws_size < WS_NEED || out_size != NTOK * DM) { fprintf(stderr, "kernel_launch: unexpected shapes (n_in %d, ws %zu need %zu, out %d)\n", n_in, ws_size, (size_t)WS_NEED, out_size); grid = -1; return; }
        int dev = 0, cus = 0, per_cu = 0;
        hipGetDevice(&dev); hipDeviceGetAttribute(&cus, hipDeviceAttributeMultiprocessorCount, dev);
        hipFuncSetAttribute((const void*)k_mega, hipFuncAttributeMaxDynamicSharedMemorySize, LDS_BYTES);
        hipFuncSetAttribute((const void*)k_phase, hipFuncAttributeMaxDynamicSharedMemorySize, LDS_BYTES);
        hipOccupancyMaxActiveBlocksPerMultiprocessor(&per_cu, (const void*)k_mega, 512, LDS_BYTES);
        if (per_cu < 1) { fprintf(stderr, "kernel_launch: occupancy query says %d blocks per CU\n", per_cu); per_cu = 1; }
        grid = cus * per_cu; if (grid > 256) grid = 256;
        (void)hipGetLastError();
    }
    if (grid < 0) return;
    Params P{};
    const float** pp = (const float**)&P;
    for (int i = 0; i < 21; ++i) pp[i] = (const float*)d_in[i];
    P.out = (float*)d_out; P.ws = (unsigned char*)d_ws;
#if ONE_LAUNCH
    if (hipMemsetAsync((unsigned char*)d_ws + O_BAR, 0, BAR_BYTES, stream) != hipSuccess) { fprintf(stderr, "kernel_launch: memset of the barrier words failed\n"); return; }
    void* args[] = {&P};
    hipError_t e = hipLaunchCooperativeKernel((const void*)k_mega, dim3(grid), dim3(512), args, LDS_BYTES, stream);
    if (e != hipSuccess) fprintf(stderr, "cooperative launch failed: %s (grid %d)\n", hipGetErrorString(e), grid);
#else
    for (int ph = 0; ph < NPH; ++ph) hipLaunchKernelGGL(k_phase, dim3(grid), dim3(512), LDS_BYTES, stream, P, ph);
#endif
}
```
